# Optimizing an MI355X kernel written in HIP

```python
import jax, jax.numpy as jnp
from jax import lax
import numpy as np

D_MODEL = 1024
BATCH = 4
SEQ = 8192
DEPTH = 1

MLA_HEADS = 8
MLA_NOPE = 128
MLA_ROPE = 64
MLA_V = 128
MLA_Q_LORA = 256
MLA_KV_LORA = 256
ROPE_THETA = 10000.0
FOX_HEADS = 16
FOX_HD = 64
ATTN_BLOCK = 128
IN_SPLITS = (MLA_Q_LORA, MLA_KV_LORA, MLA_ROPE,
             FOX_HEADS * FOX_HD, FOX_HEADS * FOX_HD, FOX_HEADS * FOX_HD, FOX_HEADS,
             D_MODEL, D_MODEL)
IN_COLS = sum(IN_SPLITS)
IN_OFFSETS = tuple(int(v) for v in np.cumsum(IN_SPLITS)[:-1])
N_EXPERTS = 32
TOP_K = 4
EXPERT_FF = D_MODEL
SWIGLU_LIMIT = 7.0
SWIGLU_ALPHA = 1.702
MOE_BLOCK = 128
PLE_DIM = 256
EPS = 1e-6

kernel_name = "hybrid_mla_fox_moe_block"


def rms_norm(x, g):
    xf = x.astype(jnp.float32)
    y = xf * lax.rsqrt(jnp.mean(xf * xf, axis=-1, keepdims=True) + EPS)
    return (y * g.astype(jnp.float32)).astype(x.dtype)


def rope_tables(seq_len):
    pos = jnp.arange(seq_len, dtype=jnp.float32)
    inv_freq = ROPE_THETA ** (-jnp.arange(0, MLA_ROPE, 2, dtype=jnp.float32) / MLA_ROPE)
    ang = pos[:, None] * inv_freq[None, :]
    return jnp.cos(ang), jnp.sin(ang)


def apply_rope(x, cos, sin):
    half = x.shape[-1] // 2
    xf = x.astype(jnp.float32)
    x1, x2 = xf[..., :half], xf[..., half:]
    c, s = cos[:, None, :], sin[:, None, :]
    return jnp.concatenate([x1 * c - x2 * s, x2 * c + x1 * s], axis=-1).astype(x.dtype)


def causal_block_attention(q, k, v, scale, log_f_cum=None):
    B, H, S, _ = q.shape
    dv = v.shape[-1]
    n_blocks = S // ATTN_BLOCK
    offs = jnp.arange(ATTN_BLOCK, dtype=jnp.int32)

    def one_query_block(i):
        q0 = i * ATTN_BLOCK
        q_i = lax.dynamic_slice_in_dim(q, q0, ATTN_BLOCK, axis=2)
        q_pos = q0 + offs
        if log_f_cum is not None:
            fq = lax.dynamic_slice_in_dim(log_f_cum, q0, ATTN_BLOCK, axis=2)

        def body(j, carry):
            m, l, acc = carry
            k0 = j * ATTN_BLOCK
            k_j = lax.dynamic_slice_in_dim(k, k0, ATTN_BLOCK, axis=2)
            v_j = lax.dynamic_slice_in_dim(v, k0, ATTN_BLOCK, axis=2)
            s = jnp.einsum("bhqd,bhkd->bhqk", q_i, k_j, preferred_element_type=jnp.float32) * scale
            if log_f_cum is not None:
                fk = lax.dynamic_slice_in_dim(log_f_cum, k0, ATTN_BLOCK, axis=2)
                s = s + fq[..., :, None] - fk[..., None, :]
            s = jnp.where(q_pos[:, None] >= (k0 + offs)[None, :], s, -jnp.inf)
            m_new = jnp.maximum(m, jnp.max(s, axis=-1))
            corr = jnp.exp(m - m_new)
            pr = jnp.exp(s - m_new[..., None])
            l_new = l * corr + jnp.sum(pr, axis=-1)
            acc_new = acc * corr[..., None] + jnp.einsum(
                "bhqk,bhkd->bhqd", pr.astype(v.dtype), v_j, preferred_element_type=jnp.float32)
            return m_new, l_new, acc_new

        init = (jnp.full((B, H, ATTN_BLOCK), -jnp.inf, jnp.float32),
                jnp.zeros((B, H, ATTN_BLOCK), jnp.float32),
                jnp.zeros((B, H, ATTN_BLOCK, dv), jnp.float32))
        _, l, acc = lax.fori_loop(0, i + 1, body, init)
        return (acc / l[..., None]).astype(q.dtype)

    out = lax.map(one_query_block, jnp.arange(n_blocks, dtype=jnp.int32))
    return out.transpose(1, 2, 0, 3, 4).reshape(B, H, S, dv)


def hybrid_mixer(h, cos, sin, w_in, q_a_norm, w_uq, kv_a_norm, w_ukv,
                 mla_q_nope_norm, mla_q_rope_norm, mla_k_nope_norm, mla_k_rope_norm,
                 fox_q_norm, fox_k_norm, fox_f_bias, w_o_mla, w_o_fox, w_o):
    B, S, _ = h.shape
    z = h @ w_in
    c_q, c_kv, k_r, fq, fk, fv, f_logit, g_mla, g_fox = jnp.split(z, IN_OFFSETS, axis=-1)

    q = (rms_norm(c_q, q_a_norm) @ w_uq).reshape(B, S, MLA_HEADS, MLA_NOPE + MLA_ROPE)
    kv = (rms_norm(c_kv, kv_a_norm) @ w_ukv).reshape(B, S, MLA_HEADS, MLA_NOPE + MLA_V)
    q_nope = rms_norm(q[..., :MLA_NOPE], mla_q_nope_norm)
    q_rope = apply_rope(rms_norm(q[..., MLA_NOPE:], mla_q_rope_norm), cos, sin)
    k_nope = rms_norm(kv[..., :MLA_NOPE], mla_k_nope_norm)
    v_mla = kv[..., MLA_NOPE:]
    k_rope = apply_rope(rms_norm(k_r, mla_k_rope_norm)[:, :, None, :], cos, sin)
    q_mla = jnp.concatenate([q_nope, q_rope], axis=-1)
    k_mla = jnp.concatenate(
        [k_nope, jnp.broadcast_to(k_rope, (B, S, MLA_HEADS, MLA_ROPE))], axis=-1)
    o_mla = causal_block_attention(q_mla.transpose(0, 2, 1, 3), k_mla.transpose(0, 2, 1, 3),
                                   v_mla.transpose(0, 2, 1, 3), (MLA_NOPE + MLA_ROPE) ** -0.5)
    o_mla = o_mla.transpose(0, 2, 1, 3).reshape(B, S, MLA_HEADS * MLA_V)

    fq = rms_norm(fq.reshape(B, S, FOX_HEADS, FOX_HD), fox_q_norm)
    fk = rms_norm(fk.reshape(B, S, FOX_HEADS, FOX_HD), fox_k_norm)
    fv = fv.reshape(B, S, FOX_HEADS, FOX_HD)
    log_f = jax.nn.log_sigmoid(f_logit.astype(jnp.float32) + fox_f_bias.astype(jnp.float32))
    f_cum = lax.cumsum(log_f, axis=1).transpose(0, 2, 1)
    o_fox = causal_block_attention(fq.transpose(0, 2, 1, 3), fk.transpose(0, 2, 1, 3),
                                   fv.transpose(0, 2, 1, 3), FOX_HD ** -0.5, log_f_cum=f_cum)
    o_fox = o_fox.transpose(0, 2, 1, 3).reshape(B, S, FOX_HEADS * FOX_HD)

    mixed = jax.nn.sigmoid(g_mla) * (o_mla @ w_o_mla) + jax.nn.sigmoid(g_fox) * (o_fox @ w_o_fox)
    return mixed @ w_o


def moe_swiglu(h, w_router, b_router, w_up, b_up, w_down, b_down):
    B, S, D = h.shape
    N = B * S
    NK = N * TOP_K
    xf = h.reshape(N, D)
    logits = jnp.einsum("nd,de->ne", xf, w_router, preferred_element_type=jnp.float32) \
        + b_router.astype(jnp.float32)
    top_val, top_idx = lax.top_k(logits, TOP_K)
    gates = jax.nn.softmax(top_val, axis=-1)

    expert_of = top_idx.reshape(-1).astype(jnp.int32)
    token_of = jnp.repeat(jnp.arange(N, dtype=jnp.int32), TOP_K)
    gate_of = gates.reshape(-1)
    order = jnp.argsort(expert_of)
    e_sorted = expert_of[order]
    counts = jnp.bincount(expert_of, length=N_EXPERTS).astype(jnp.int32)
    starts = jnp.cumsum(counts) - counts
    padded = (counts + MOE_BLOCK - 1) // MOE_BLOCK * MOE_BLOCK
    pad_ends = jnp.cumsum(padded)
    pad_starts = pad_ends - padded
    dest = pad_starts[e_sorted] + (jnp.arange(NK, dtype=jnp.int32) - starts[e_sorted])
    n_rows = NK + N_EXPERTS * MOE_BLOCK
    n_blocks = n_rows // MOE_BLOCK
    row_token = jnp.full((n_rows,), N, jnp.int32).at[dest].set(token_of[order])
    row_gate = jnp.zeros((n_rows,), jnp.float32).at[dest].set(gate_of[order])
    block_expert = jnp.minimum(
        jnp.searchsorted(pad_ends, jnp.arange(n_blocks, dtype=jnp.int32) * MOE_BLOCK, side="right"),
        N_EXPERTS - 1)
    x_rows = jnp.concatenate([xf, jnp.zeros((1, D), xf.dtype)], axis=0)[row_token]
    x_rows = x_rows.reshape(n_blocks, MOE_BLOCK, D)

    def expert_block(args):
        xb, e = args
        gu = xb @ w_up[e] + b_up[e]
        g, u = gu[..., :EXPERT_FF], gu[..., EXPERT_FF:]
        g = jnp.minimum(g, SWIGLU_LIMIT)
        u = jnp.clip(u, -SWIGLU_LIMIT, SWIGLU_LIMIT)
        act = g * jax.nn.sigmoid(SWIGLU_ALPHA * g) * (u + 1.0)
        return act @ w_down[e] + b_down[e]

    y_rows = lax.map(expert_block, (x_rows, block_expert)).reshape(n_rows, D)
    y = jnp.zeros((N + 1, D), jnp.float32).at[row_token].add(
        y_rows.astype(jnp.float32) * row_gate[:, None])[:N]
    return y.reshape(B, S, D).astype(h.dtype)


def setup_inputs(seed: int = 0) -> dict:
    key = jax.random.key(seed)
    ks = jax.random.split(key, 28)
    L = DEPTH
    f32 = jnp.float32

    def w(k, shape, fan_in):
        return jax.random.normal(k, shape, f32) * fan_in ** -0.5

    def gain(k, n):
        return 1.0 + 0.05 * jax.random.normal(k, (L, n), f32)

    def small(k, shape):
        return 0.01 * jax.random.normal(k, shape, f32)

    return {
        "x": jax.random.normal(ks[0], (BATCH, SEQ, D_MODEL), f32),
        "p": jax.random.normal(ks[1], (DEPTH, BATCH, SEQ, PLE_DIM), f32),
        "attn_norm": gain(ks[2], D_MODEL),
        "w_in": w(ks[3], (L, D_MODEL, IN_COLS), D_MODEL),
        "q_a_norm": gain(ks[4], MLA_Q_LORA),
        "w_uq": w(ks[5], (L, MLA_Q_LORA, MLA_HEADS * (MLA_NOPE + MLA_ROPE)), MLA_Q_LORA),
        "kv_a_norm": gain(ks[6], MLA_KV_LORA),
        "w_ukv": w(ks[7], (L, MLA_KV_LORA, MLA_HEADS * (MLA_NOPE + MLA_V)), MLA_KV_LORA),
        "mla_q_nope_norm": gain(ks[8], MLA_NOPE),
        "mla_q_rope_norm": gain(ks[9], MLA_ROPE),
        "mla_k_nope_norm": gain(ks[10], MLA_NOPE),
        "mla_k_rope_norm": gain(ks[11], MLA_ROPE),
        "fox_q_norm": gain(ks[12], FOX_HD),
        "fox_k_norm": gain(ks[13], FOX_HD),
        "fox_f_bias": jax.random.uniform(ks[14], (L, FOX_HEADS), f32, minval=1.0, maxval=6.0),
        "w_o_mla": w(ks[15], (L, MLA_HEADS * MLA_V, D_MODEL), MLA_HEADS * MLA_V),
        "w_o_fox": w(ks[16], (L, FOX_HEADS * FOX_HD, D_MODEL), FOX_HEADS * FOX_HD),
        "w_o": w(ks[17], (L, D_MODEL, D_MODEL), D_MODEL),
        "ffn_norm": gain(ks[18], D_MODEL),
        "w_router": w(ks[19], (L, D_MODEL, N_EXPERTS), D_MODEL),
        "b_router": small(ks[20], (L, N_EXPERTS)),
        "w_up": w(ks[21], (L, N_EXPERTS, D_MODEL, 2 * EXPERT_FF), D_MODEL),
        "b_up": small(ks[22], (L, N_EXPERTS, 2 * EXPERT_FF)),
        "w_down": w(ks[23], (L, N_EXPERTS, EXPERT_FF, D_MODEL), EXPERT_FF),
        "b_down": small(ks[24], (L, N_EXPERTS, D_MODEL)),
        "ple_norm": gain(ks[25], D_MODEL),
        "w_ple_gate": w(ks[26], (L, D_MODEL, D_MODEL), D_MODEL),
        "w_ple_proj": w(ks[27], (L, PLE_DIM, D_MODEL), PLE_DIM),
    }


def reference(x, p, attn_norm, w_in, q_a_norm, w_uq, kv_a_norm, w_ukv,
              mla_q_nope_norm, mla_q_rope_norm, mla_k_nope_norm, mla_k_rope_norm,
              fox_q_norm, fox_k_norm, fox_f_bias, w_o_mla, w_o_fox, w_o,
              ffn_norm, w_router, b_router, w_up, b_up, w_down, b_down,
              ple_norm, w_ple_gate, w_ple_proj):
    cos, sin = rope_tables(x.shape[1])
    for i in range(DEPTH):
        h = rms_norm(x, attn_norm[i])
        x = x + hybrid_mixer(h, cos, sin, w_in[i], q_a_norm[i], w_uq[i], kv_a_norm[i], w_ukv[i],
                             mla_q_nope_norm[i], mla_q_rope_norm[i], mla_k_nope_norm[i],
                             mla_k_rope_norm[i], fox_q_norm[i], fox_k_norm[i], fox_f_bias[i],
                             w_o_mla[i], w_o_fox[i], w_o[i])
        h = rms_norm(x, ffn_norm[i])
        x = x + moe_swiglu(h, w_router[i], b_router[i], w_up[i], b_up[i], w_down[i], b_down[i])
        ple_gate = jax.nn.sigmoid(rms_norm(x, ple_norm[i]) @ w_ple_gate[i])
        x = x + ple_gate * (p[i] @ w_ple_proj[i])
    return x
```

```cpp
#include <hip/hip_runtime.h>
#include <hip/hip_cooperative_groups.h>
#include <cstdio>
#include <cstdint>
namespace cg = cooperative_groups;
#ifndef ATT_F8
#define ATT_F8 1
#endif
#ifndef F8_P1
#define F8_P1 1
#endif
#ifndef P1_F8_TILE0
#define P1_F8_TILE0 0
#endif
#ifndef F8_P4
#define F8_P4 0
#endif
#ifndef F8_P5
#define F8_P5 0
#endif
#ifndef F8_PLE
#define F8_PLE 1
#endif
#ifndef WGM_WIDE
#define WGM_WIDE 4
#endif
#ifndef WGM_DENSE
#define WGM_DENSE 4
#endif
#ifndef WGM_UP
#define WGM_UP 4
#endif
#ifndef WGM_DOWN
#define WGM_DOWN 4
#endif
#ifndef FOX_PIPE
#define FOX_PIPE 1
#ifndef P4_CHAIN
#define P4_CHAIN 1
#endif
#ifndef FOX_KT256
#define FOX_KT256 1
#endif
#ifndef MLA_KT128
#define MLA_KT128 1
#endif
#ifndef FOX_BIAS_MFMA
#define FOX_BIAS_MFMA 1
#endif
#endif
#ifndef MLA_PIPE
#define MLA_PIPE 0
#endif

typedef unsigned short bf16_t;
typedef short bf16x8 __attribute__((ext_vector_type(8)));
typedef float f32x4 __attribute__((ext_vector_type(4)));
typedef float f32x2 __attribute__((ext_vector_type(2)));
typedef unsigned u32x4 __attribute__((ext_vector_type(4)));
typedef unsigned u32x2 __attribute__((ext_vector_type(2)));

constexpr int NTOK = 32768, SEQ = 8192, BATCH = 4, DM = 1024;
constexpr int OFF_CQ = 0, OFF_CKV = 256, OFF_KR = 512, OFF_FQ = 576, OFF_FK = 1600, OFF_FV = 2624, OFF_FL = 3648, OFF_GM = 3664, OFF_GF = 4688, IN_COLS = 5712;
constexpr int ZP = 5888;
constexpr int NEXP = 32, TOPK = 4, EFF = 1024;
constexpr int NTHREADS = 512, NWAVES = 8;
constexpr float EPS = 1e-6f;
constexpr float LOG2E = 1.4426950408889634f;
constexpr float C2_MLA = 0.07216878364870322f * LOG2E;
constexpr float C2_FOX = 0.125f * LOG2E;
constexpr int MAXTILES = 544;

constexpr size_t MiB = 1u << 20;
constexpr size_t WS_CTL = 0;
constexpr size_t WS_RSTD1 = 1 * MiB;
constexpr size_t WS_RSTD2 = WS_RSTD1 + 256 * 1024;
constexpr size_t WS_RSTD3 = WS_RSTD2 + 256 * 1024;
constexpr size_t WS_GATE = 2 * MiB;
constexpr size_t WS_LIST = 3 * MiB;
constexpr size_t WS_LISTR = 968 * MiB, WS_LISTG = 976 * MiB;
constexpr size_t WS_FL = 7 * MiB;
constexpr size_t WS_LF = 9 * MiB;
constexpr size_t WS_FC = 11 * MiB;
constexpr size_t WS_FCR = 32 * MiB;
constexpr size_t WS_ROPE = 13 * MiB;
constexpr size_t WS_WR3 = 15 * MiB;
constexpr size_t WS_KR8 = 7 * MiB;
constexpr size_t WS_FQ8 = 120 * MiB, WS_FK8 = 152 * MiB;
constexpr size_t WS_QM8 = 616 * MiB;
constexpr size_t WS_K8 = 664 * MiB;
constexpr size_t WS_PB = 16 * MiB;
constexpr size_t WS_WIN8 = 216 * MiB;
constexpr size_t WS_XF8 = 680 * MiB;
constexpr size_t WS_WIN = 32 * MiB;
constexpr size_t WS_WUQ = 44 * MiB;
constexpr size_t WS_WUKV = 45 * MiB;
constexpr size_t WS_WOMLA = 46 * MiB, WS_WOFOX = 48 * MiB, WS_WO = 50 * MiB, WS_WPG = 52 * MiB, WS_WPP = 54 * MiB;
constexpr size_t WS_WUP = 56 * MiB;
constexpr size_t WS_WDOWN = 184 * MiB;
constexpr size_t WS_Z = 248 * MiB;
constexpr size_t WS_H = 248 * MiB;
constexpr size_t WS_TMP = 320 * MiB;
constexpr size_t WS_QM = 616 * MiB;
constexpr size_t WS_XB = 616 * MiB;
constexpr size_t WS_MIXED = 776 * MiB;
constexpr size_t WS_X1B = 616 * MiB;
constexpr size_t WS_X2F8 = 384 * MiB;
constexpr size_t WS_X2B = 248 * MiB;
constexpr size_t WS_X1F8 = 684 * MiB;
constexpr size_t WS_KVM = 712 * MiB;
constexpr size_t WS_MIXTMP = 712 * MiB;
constexpr size_t WS_OM = 840 * MiB, WS_OF = 904 * MiB;
constexpr size_t WS_Y = 712 * MiB;
constexpr size_t WS_CQN = 968 * MiB, WS_CKVN = 984 * MiB;
constexpr size_t WS_KR = 1000 * MiB;
constexpr size_t WS_END = 1004 * MiB;
constexpr int LDS_BYTES = 150 * 1024;

__device__ __forceinline__ float bf2f(unsigned b) { return __uint_as_float(b << 16); }
__device__ __forceinline__ unsigned f2bf(float f) { unsigned u = __float_as_uint(f); return (u + 0x7fffu + ((u >> 16) & 1u)) >> 16; }
__device__ __forceinline__ unsigned pk2(float lo, float hi) { unsigned r; asm("v_cvt_pk_bf16_f32 %0, %1, %2" : "=v"(r) : "v"(lo), "v"(hi)); return r; }
__device__ __forceinline__ u32x2 pk4(f32x4 v) { u32x2 r; r.x = pk2(v[0], v[1]); r.y = pk2(v[2], v[3]); return r; }
__device__ __forceinline__ f32x4 unpk4(u32x2 w) { f32x4 r; r[0] = bf2f(w.x & 0xffffu); r[1] = bf2f(w.x >> 16); r[2] = bf2f(w.y & 0xffffu); r[3] = bf2f(w.y >> 16); return r; }
__device__ __forceinline__ float sigmoidf_(float x) { return __builtin_amdgcn_rcpf(1.0f + __builtin_amdgcn_exp2f(-LOG2E * x)); }
__device__ __forceinline__ float wave_sum(float v) {
#pragma unroll
    for (int o = 1; o < 64; o <<= 1) v += __shfl_xor(v, o);
    return v;
}
typedef int v8i __attribute__((ext_vector_type(8)));
typedef int v4i __attribute__((ext_vector_type(4)));
constexpr float F8_SW = 512.0f, F8_SX = 16.0f, F8_SH = 8.0f;
__device__ __forceinline__ unsigned pk4_fp8(f32x4 v) { int r = __builtin_amdgcn_cvt_pk_fp8_f32(v[0], v[1], 0, false); r = __builtin_amdgcn_cvt_pk_fp8_f32(v[2], v[3], r, true); return (unsigned)r; }
__device__ __forceinline__ unsigned pk4_fp8s(f32x4 v) {
    const float a = __builtin_amdgcn_fmed3f(v[0], -448.f, 448.f), b = __builtin_amdgcn_fmed3f(v[1], -448.f, 448.f), c = __builtin_amdgcn_fmed3f(v[2], -448.f, 448.f), d = __builtin_amdgcn_fmed3f(v[3], -448.f, 448.f);
    int r = __builtin_amdgcn_cvt_pk_fp8_f32(a, b, 0, false); r = __builtin_amdgcn_cvt_pk_fp8_f32(c, d, r, true); return (unsigned)r; }
__device__ __forceinline__ f32x4 mfma16f8(bf16x8 alo, bf16x8 ahi, bf16x8 blo, bf16x8 bhi, f32x4 c) {
    const v4i a0 = __builtin_bit_cast(v4i, alo), a1 = __builtin_bit_cast(v4i, ahi), b0 = __builtin_bit_cast(v4i, blo), b1 = __builtin_bit_cast(v4i, bhi);
    const v8i a = __builtin_shufflevector(a0, a1, 0, 1, 2, 3, 4, 5, 6, 7), b = __builtin_shufflevector(b0, b1, 0, 1, 2, 3, 4, 5, 6, 7);
    return __builtin_amdgcn_mfma_scale_f32_16x16x128_f8f6f4(a, b, c, 0, 0, 0, 0x7f7f7f7f, 0, 0x7f7f7f7f); }
__device__ __forceinline__ f32x4 mfma16(bf16x8 a, bf16x8 b, f32x4 c) { return __builtin_amdgcn_mfma_f32_16x16x32_bf16(a, b, c, 0, 0, 0); }

struct Args { const float* in[28]; float* out; unsigned char* ws; };
__device__ __forceinline__ void rope_cs(int pos, int i, float& c, float& s) {
    const float inv = exp2f(-(float)(2 * i) * (13.287712379549449f / 64.0f));
    const float ang = (float)pos * inv;
    const double rev = (double)ang * 0.15915494309189535; const double fr = rev - rint(rev);
    const float f = (float)fr; c = __builtin_amdgcn_cosf(f); s = __builtin_amdgcn_sinf(f);
}


template <int MODE  >
__device__ __forceinline__ void transpose_item(const float* W, int ldw, int nvalid, int K, bf16_t* Wt, const float* gain, float* scr, int kb, int nb, int lane) {
    const int k0 = 64 * kb, n0 = 32 * nb, c4 = lane & 7, rr = lane >> 3;
    f32x4 v[8];
#pragma unroll
    for (int i = 0; i < 8; ++i) {
        const int kk = rr + 8 * i, n = n0 + 4 * c4;
        v[i] = (n < nvalid) ? *(const f32x4*)(W + (size_t)(k0 + kk) * ldw + n) : (f32x4){0.f, 0.f, 0.f, 0.f};
        if (gain) v[i] = v[i] * gain[k0 + kk];
    }
#pragma unroll
    for (int i = 0; i < 8; ++i) { float* d = scr + (rr + 8 * i) * 33 + 4 * c4; d[0] = v[i][0]; d[1] = v[i][1]; d[2] = v[i][2]; d[3] = v[i][3]; }
    asm volatile("s_waitcnt lgkmcnt(0)" ::: "memory");
    const int c = lane & 7;
#pragma unroll
    for (int j = 0; j < 4; ++j) {
        const int n = (lane >> 3) + 8 * j; const float* s = scr + (8 * c) * 33 + n;
        u32x4 o; o.x = pk2(s[0 * 33], s[1 * 33]); o.y = pk2(s[2 * 33], s[3 * 33]); o.z = pk2(s[4 * 33], s[5 * 33]); o.w = pk2(s[6 * 33], s[7 * 33]);
        int L = n0 + n, drow = (L & ~31) + 16 * ((L >> 2) & 1) + 4 * ((L >> 3) & 3) + (L & 3);
        if (MODE == 1) { const int half = L >> 10, cc = L & 1023, w32 = cc & 31;
            drow = 256 * (cc >> 7) + 128 * half + 32 * ((cc & 127) >> 5) + 16 * ((w32 >> 2) & 1) + 4 * ((w32 >> 3) & 3) + (w32 & 3); }
        if (MODE == 2 || MODE == 3) {
            const int Lp = (MODE == 2) ? ((L / 192) * 256 + (L % 192)) : L; const int T = Lp >> 8, lb = (Lp & 255) >> 5, w = Lp & 31;
            drow = 256 * T + 32 * (4 * (lb & 1) + (lb >> 1)) + 16 * ((w >> 2) & 1) + 4 * ((w >> 3) & 3) + (w & 3); }
        *(u32x4*)(Wt + (size_t)drow * K + k0 + 8 * c) = o;
    }
    asm volatile("s_waitcnt lgkmcnt(0)" ::: "memory");
}


template <int MODE>
__device__ __forceinline__ void transpose_item8(const float* W, int ldw, int K, unsigned char* Wt, const float* gain, float* scr, int kb, int nb, int lane) {
    const int k0 = 64 * kb, n0 = 32 * nb, c4 = lane & 7, rr = lane >> 3;
    f32x4 v[8];
#pragma unroll
    for (int i = 0; i < 8; ++i) { const int kk = rr + 8 * i; v[i] = (n0 + 4 * c4 < ldw) ? *(const f32x4*)(W + (size_t)(k0 + kk) * ldw + n0 + 4 * c4) : (f32x4){0.f, 0.f, 0.f, 0.f}; v[i] = v[i] * ((gain ? gain[k0 + kk] : 1.0f) * F8_SW); }
#pragma unroll
    for (int i = 0; i < 8; ++i) { float* d = scr + (rr + 8 * i) * 33 + 4 * c4; d[0] = v[i][0]; d[1] = v[i][1]; d[2] = v[i][2]; d[3] = v[i][3]; }
    asm volatile("s_waitcnt lgkmcnt(0)" ::: "memory");
    const int n = lane >> 1, kh = 32 * (lane & 1); const float* sp = scr + kh * 33 + n; unsigned w[8];
#pragma unroll
    for (int q = 0; q < 8; ++q) w[q] = pk4_fp8s((f32x4){sp[(4 * q) * 33], sp[(4 * q + 1) * 33], sp[(4 * q + 2) * 33], sp[(4 * q + 3) * 33]});
    const int L = n0 + n; int drow = (L & ~31) + 16 * ((L >> 2) & 1) + 4 * ((L >> 3) & 3) + (L & 3);
    if (MODE == 1) { const int half = L >> 10, cc = L & 1023, w32 = cc & 31; drow = 256 * (cc >> 7) + 128 * half + 32 * ((cc & 127) >> 5) + 16 * ((w32 >> 2) & 1) + 4 * ((w32 >> 3) & 3) + (w32 & 3); }
    if (MODE == 3) { const int T = L >> 8, lb = (L & 255) >> 5, w = L & 31; drow = 256 * T + 32 * (4 * (lb & 1) + (lb >> 1)) + 16 * ((w >> 2) & 1) + 4 * ((w >> 3) & 3) + (w & 3); }
    unsigned char* dp = Wt + (size_t)drow * K + k0 + kh;
    *(u32x4*)dp = (u32x4){w[0], w[1], w[2], w[3]}; *(u32x4*)(dp + 16) = (u32x4){w[4], w[5], w[6], w[7]};
    asm volatile("s_waitcnt lgkmcnt(0)" ::: "memory");
}

__device__ __forceinline__ void phase_prologue(const Args& a, char* lds, int gw, int ngw, int wave, int lane) {
    float* scr = (float*)(lds + wave * 16384);
    unsigned char* ws = a.ws;
    constexpr int I_WIN = 16 * 179, I_WUQ = 4 * 48, I_WUKV = 4 * 64, I_SQ = 16 * 32, I_WPP = 4 * 32, I_UP = 16 * 64, I_DN = 16 * 32;
    constexpr int NITEMS = I_WIN + I_WUQ + I_WUKV + 4 * I_SQ + I_WPP + NEXP * I_UP + NEXP * I_DN;
    for (int it = gw; it < NITEMS; it += ngw) {
        int r = it;
        if (r < I_WIN) { if (F8_P1 && ((r % 179) * 32) / 256 >= P1_F8_TILE0) transpose_item8<3>(a.in[3], IN_COLS, 1024, (unsigned char*)(ws + WS_WIN8), a.in[2], scr, r / 179, r % 179, lane); else transpose_item<3>(a.in[3], IN_COLS, IN_COLS, 1024, (bf16_t*)(ws + WS_WIN), a.in[2], scr, r / 179, r % 179, lane); continue; } r -= I_WIN;
        if (r < I_WUQ) { transpose_item<2>(a.in[5], 1536, 1536, 256, (bf16_t*)(ws + WS_WUQ), a.in[4], scr, r / 48, r % 48, lane); continue; } r -= I_WUQ;
        if (r < I_WUKV) { transpose_item<3>(a.in[7], 2048, 2048, 256, (bf16_t*)(ws + WS_WUKV), a.in[6], scr, r / 64, r % 64, lane); continue; } r -= I_WUKV;
        if (r < I_SQ) { if (F8_P4) transpose_item8<0>(a.in[15], 1024, 1024, (unsigned char*)(ws + WS_WOMLA), nullptr, scr, r / 32, r % 32, lane); else transpose_item<0>(a.in[15], 1024, 1024, 1024, (bf16_t*)(ws + WS_WOMLA), nullptr, scr, r / 32, r % 32, lane); continue; } r -= I_SQ;
        if (r < I_SQ) { if (F8_P4) transpose_item8<0>(a.in[16], 1024, 1024, (unsigned char*)(ws + WS_WOFOX), nullptr, scr, r / 32, r % 32, lane); else transpose_item<0>(a.in[16], 1024, 1024, 1024, (bf16_t*)(ws + WS_WOFOX), nullptr, scr, r / 32, r % 32, lane); continue; } r -= I_SQ;
        if (r < I_SQ) { if (F8_P5) transpose_item8<0>(a.in[17], 1024, 1024, (unsigned char*)(ws + WS_WO), nullptr, scr, r / 32, r % 32, lane); else transpose_item<0>(a.in[17], 1024, 1024, 1024, (bf16_t*)(ws + WS_WO), nullptr, scr, r / 32, r % 32, lane); continue; } r -= I_SQ;
        if (r < I_SQ) { if (F8_PLE) transpose_item8<0>(a.in[26], 1024, 1024, (unsigned char*)(ws + WS_WPG), a.in[25], scr, r / 32, r % 32, lane); else transpose_item<0>(a.in[26], 1024, 1024, 1024, (bf16_t*)(ws + WS_WPG), a.in[25], scr, r / 32, r % 32, lane); continue; } r -= I_SQ;
        if (r < I_WPP) { transpose_item<0>(a.in[27], 1024, 1024, 256, (bf16_t*)(ws + WS_WPP), nullptr, scr, r / 32, r % 32, lane); continue; } r -= I_WPP;
        if (r < NEXP * I_UP) { const int e = r / I_UP, q = r % I_UP;
            transpose_item8<1>(a.in[21] + (size_t)e * 1024 * 2048, 2048, 1024, (unsigned char*)(ws + WS_WUP) + (size_t)e * 2048 * 1024, a.in[18], scr, q / 64, q % 64, lane); continue; } r -= NEXP * I_UP;
        { const int e = r / I_DN, q = r % I_DN;
            transpose_item8<0>(a.in[23] + (size_t)e * 1024 * 1024, 1024, 1024, (unsigned char*)(ws + WS_WDOWN) + (size_t)e * 1024 * 1024, nullptr, scr, q / 32, q % 32, lane); }
    }
    const float* x = a.in[0]; bf16_t* XB = (bf16_t*)(ws + WS_XB); float* RSTD1 = (float*)(ws + WS_RSTD1);
    for (int m = gw; m < NTOK; m += ngw) {
        const f32x4* xr = (const f32x4*)(x + (size_t)m * DM) + lane; f32x4 v[4]; float s = 0.f;
#pragma unroll
        for (int j = 0; j < 4; ++j) { v[j] = xr[64 * j]; s += (v[j][0] * v[j][0] + v[j][1] * v[j][1]) + (v[j][2] * v[j][2] + v[j][3] * v[j][3]); }
        s = wave_sum(s);
        if (lane == 0) RSTD1[m] = __builtin_amdgcn_rsqf(s * (1.0f / DM) + EPS);
        if (F8_P1) { unsigned* o8 = (unsigned*)(ws + WS_XF8 + (size_t)m * DM) + lane;
#pragma unroll
            for (int j = 0; j < 4; ++j) o8[64 * j] = pk4_fp8s(v[j] * F8_SX); }
        if (!F8_P1 || P1_F8_TILE0 > 0) { u32x2* o = (u32x2*)(XB + (size_t)m * DM) + lane;
#pragma unroll
        for (int j = 0; j < 4; ++j) o[64 * j] = pk4(v[j]); }
    }
    { f32x2* RT = (f32x2*)(ws + WS_ROPE);
      for (int idx = gw * 64 + lane; idx < SEQ * 32; idx += ngw * 64) { float c, sn; rope_cs(idx >> 5, idx & 31, c, sn); RT[idx] = (f32x2){c, sn}; } }
    { bf16_t* WR3 = (bf16_t*)(ws + WS_WR3); const float* wr = a.in[19]; const float* gf = a.in[18];
      for (int idx = gw * 64 + lane; idx < 1024 * 32; idx += ngw * 64) { const int k = idx >> 5, e = idx & 31; const float w = wr[idx] * gf[k];
          const unsigned h = f2bf(w); const float r1 = w - bf2f(h); const unsigned m = f2bf(r1); const float r2 = r1 - bf2f(m); const unsigned l = f2bf(r2);
          WR3[e * 1024 + k] = (bf16_t)h; WR3[32768 + e * 1024 + k] = (bf16_t)m; WR3[65536 + e * 1024 + k] = (bf16_t)l; } }
    const float* p = a.in[1]; bf16_t* PB = (bf16_t*)(ws + WS_PB);
    for (int m = gw; m < NTOK; m += ngw) { const f32x4 v = *((const f32x4*)(p + (size_t)m * 256) + lane); *((u32x2*)(PB + (size_t)m * 256) + lane) = pk4(v); }
}

struct UnitCtx { int row0; int e; int idx0; int cnt; const int* list; int par; };
template <class RowPtr, class Epi>
__device__ __forceinline__ void gemm_unit_simple(const RowPtr& RP, const bf16_t* Bt, int ldb, int K, int colbase, const UnitCtx& uc, const Epi& E, int wave, int lane) {
    const int fr = lane & 15, fq = lane >> 4;
    const bf16_t* a0 = RP(32 * wave + fr) + 8 * fq; const bf16_t* a1 = RP(32 * wave + 16 + fr) + 8 * fq;
    for (int cgp = 0; cgp < 4; ++cgp) {
        f32x4 acc[2][4];
#pragma unroll
        for (int i = 0; i < 2; ++i)
#pragma unroll
            for (int n = 0; n < 4; ++n) acc[i][n] = (f32x4){0.f, 0.f, 0.f, 0.f};
        const bf16_t* b = Bt + (size_t)(64 * cgp + fr) * ldb + 8 * fq;
        for (int k0 = 0; k0 < K; k0 += 32) {
            const bf16x8 av0 = *(const bf16x8*)(a0 + k0), av1 = *(const bf16x8*)(a1 + k0);
#pragma unroll
            for (int n = 0; n < 4; ++n) { const bf16x8 bv = *(const bf16x8*)(b + (size_t)16 * n * ldb + k0);
                acc[0][n] = mfma16(bv, av0, acc[0][n]); acc[1][n] = mfma16(bv, av1, acc[1][n]); }
        }
#pragma unroll
        for (int mi = 0; mi < 2; ++mi)
#pragma unroll
            for (int pp = 0; pp < 2; ++pp) E(uc, 32 * wave + 16 * mi + fr, colbase + 64 * cgp + 32 * pp, fq, acc[mi][2 * pp], acc[mi][2 * pp + 1], E.row_pre(uc, 32 * wave + 16 * mi + fr));
    }
}
struct DenseRows { const bf16_t* A; int lda; __device__ __forceinline__ const bf16_t* operator()(int r) const { return A + (size_t)r * lda; } };
template <class Epi>
__device__ __forceinline__ void gemm_dense(const bf16_t* A, int lda, const bf16_t* Bt, int M, int N, int K, const Epi& E, int wave, int lane) {
    const int nN = N / 256, nU = (M / 256) * nN;
    for (int u = blockIdx.x; u < nU; u += gridDim.x) {
        const int pm = u / nN, pn = u % nN;
        UnitCtx uc; uc.row0 = pm * 256; uc.e = 0; uc.idx0 = 0; uc.cnt = 0; uc.list = nullptr;
        DenseRows RP{A + (size_t)pm * 256 * lda, lda};
        gemm_unit_simple(RP, Bt + (size_t)pn * 256 * K, K, K, pn * 256, uc, E, wave, lane);
    }
}


#define LAS __attribute__((address_space(3)))
namespace pg8 {
constexpr int BM = 256, BK = 64, HALF = 128, HTB = HALF * BK * 2, STAGE_BYTES = 8 * HTB, NXCD = 8;
__device__ __forceinline__ int lds_byte(int r, int c) { const int st = (r >> 4) * 2 + (c >> 5), rr = r & 15, cc = c & 31, ob = rr * 64 + cc * 2; return st * 1024 + (ob ^ (((ob >> 9) & 1) << 5)); }
__device__ __forceinline__ void stage_rc(int b, int& R, int& C) { const int st = b / 1024, sb = b % 1024, swz = sb ^ (((sb >> 9) & 1) << 5); R = (st >> 1) * 16 + swz / 64; C = (st & 1) * 32 + (swz % 64) / 2; }
struct Unit { int pm, pn; };
struct StaticOrder {
    int nM, nN, nwg, G, c, WGM;
    __device__ void init(int nM_, int nN_, int G_, int c_, int wgm_ = 4) { nM = nM_; nN = nN_; nwg = nM * nN; G = G_; c = c_; WGM = wgm_; }
    __device__ bool next(int i, Unit& u) const {
        const long L = (long)i * G + c; if (L >= nwg) return false;
        int wgid = (int)L; { const int q = nwg / NXCD, r = nwg % NXCD, xcd = wgid % NXCD, off = wgid / NXCD; wgid = (xcd < r ? xcd * (q + 1) : r * (q + 1) + (xcd - r) * q) + off; }
        const int nig = WGM * nN, gid = wgid / nig, fm = gid * WGM, gsz = (nM - fm) < WGM ? (nM - fm) : WGM;
        u.pm = fm + ((wgid % nig) % gsz); u.pn = (wgid % nig) / gsz; return true;
    }
};
struct GUnit { const char* A; const char* B; UnitCtx uc; int colbase; };
template <class T, class = void> struct has_pf { static constexpr bool value = false; };
template <class T> struct has_pf<T, decltype((void)T::PF)> { static constexpr bool value = true; };
template <class T, class = void> struct has_chain { static constexpr bool value = false; };
template <class T> struct has_chain<T, decltype((void)T::CHAIN)> { static constexpr bool value = true; };
template <class T, class = void> struct is_whole { static constexpr bool value = false; };
template <class T> struct is_whole<T, decltype((void)T::WHOLE)> { static constexpr bool value = true; };

template <class Epi, class Sched, bool GATHER, bool F8 = false>
__device__ __forceinline__ void gemm_phase(LAS unsigned char* lds, const int K_in, const Sched& S, const Epi& E) {
    int K = K_in; asm volatile("" : "+s"(K));
    int tid = threadIdx.x; asm volatile("" : "+v"(tid));
    const int wid = __builtin_amdgcn_readfirstlane(tid >> 6), lane = tid & 63, wr = wid >> 2, wc = wid & 3, fr = lane & 15, fq = lane >> 4;
    const int RB = F8 ? K : 2 * K;
    const int nt = RB / 128;
    int Rr[2], Cc[2]; unsigned voffA[2];
#pragma unroll
    for (int i = 0; i < 2; ++i) { stage_rc(tid * 16 + i * 8192, Rr[i], Cc[i]); voffA[i] = (unsigned)(Rr[i] * RB + Cc[i] * 2); }
    const size_t kstep = (size_t)(BK * 2);
    const size_t hstep = (size_t)HALF * RB;
    const unsigned ldsw = (unsigned)wid * 1024u;
    const int aoff = lds_byte(wr * 64 + fr, fq * 8), boff = lds_byte(wc * 32 + fr, fq * 8);
#define PG8_SA(b, h) (((b) * 2 + (h)) * HTB)
#define PG8_SB(b, h) ((4 + (b) * 2 + (h)) * HTB)
#define PG8_RAW(bufoff, g0, g1) do { __builtin_amdgcn_global_load_lds((const unsigned*)(g0), (LAS unsigned*)(lds + (bufoff) + ldsw), 16, 0, 0); \
        __builtin_amdgcn_global_load_lds((const unsigned*)(g1), (LAS unsigned*)(lds + (bufoff) + ldsw + 8192), 16, 0, 0); } while (0)
#define PG8_STB(bufoff, bp) do { const char* p_ = (bp); PG8_RAW(bufoff, p_ + voffA[0], p_ + voffA[1]); } while (0)
#define PG8_STA(bufoff, SEL, H, KOFF) do { if constexpr (GATHER) { const unsigned o0_ = (SEL) ? offn[H][0] : offc[H][0], o1_ = (SEL) ? offn[H][1] : offc[H][1]; const char* p_ = cA + (KOFF); PG8_RAW(bufoff, p_ + o0_, p_ + o1_); } \
        else { const char* p_ = ((SEL) ? nA : cA) + (size_t)(H) * hstep + (KOFF); PG8_RAW(bufoff, p_ + voffA[0], p_ + voffA[1]); } } while (0)
#define PG8_CAT(lo, hi) __builtin_shufflevector(__builtin_bit_cast(v4i, lo), __builtin_bit_cast(v4i, hi), 0, 1, 2, 3, 4, 5, 6, 7)
#define PG8_LDA(dst, b, h) do { if constexpr (F8) { _Pragma("unroll") for (int m = 0; m < 4; ++m) dst##8[m] = PG8_CAT(*(const LAS bf16x8*)(lds + PG8_SA(b, h) + aoff + m * 2048), *(const LAS bf16x8*)(lds + PG8_SA(b, h) + aoff + m * 2048 + 1024)); } \
        else { _Pragma("unroll") for (int m = 0; m < 4; ++m) _Pragma("unroll") for (int k = 0; k < 2; ++k) dst[m][k] = *(const LAS bf16x8*)(lds + PG8_SA(b, h) + aoff + m * 2048 + k * 1024); } } while (0)
#define PG8_LDB(dst, b, h) do { if constexpr (F8) { _Pragma("unroll") for (int n = 0; n < 2; ++n) dst##8[n] = PG8_CAT(*(const LAS bf16x8*)(lds + PG8_SB(b, h) + boff + n * 2048), *(const LAS bf16x8*)(lds + PG8_SB(b, h) + boff + n * 2048 + 1024)); } \
        else { _Pragma("unroll") for (int n = 0; n < 2; ++n) _Pragma("unroll") for (int k = 0; k < 2; ++k) dst[n][k] = *(const LAS bf16x8*)(lds + PG8_SB(b, h) + boff + n * 2048 + k * 1024); } } while (0)
#define PG8_MMA(ai, bj, At, Bt) do { __builtin_amdgcn_s_setprio(1); \
        if constexpr (F8) { _Pragma("unroll") for (int m = 0; m < 4; ++m) _Pragma("unroll") for (int n = 0; n < 2; ++n) \
            asm volatile("v_mfma_scale_f32_16x16x128_f8f6f4 %0, %1, %2, %0, %3, %3 op_sel_hi:[0,0,0]" : "+v"(acc[ai][bj][m][n]) : "v"(Bt##8[n]), "v"(At##8[m]), "v"(f8scale)); } \
        else { _Pragma("unroll") for (int m = 0; m < 4; ++m) _Pragma("unroll") for (int n = 0; n < 2; ++n) _Pragma("unroll") for (int k = 0; k < 2; ++k) \
            acc[ai][bj][m][n] = __builtin_amdgcn_mfma_f32_16x16x32_bf16(Bt[n][k], At[m][k], acc[ai][bj][m][n], 0, 0, 0); } \
        __builtin_amdgcn_s_setprio(0); } while (0)
#define PG8_WAIT_V(n) asm volatile("s_waitcnt vmcnt(" #n ")" ::: "memory")
#define PG8_WAIT_L(n) asm volatile("s_waitcnt lgkmcnt(" #n ")" ::: "memory")
#define PG8_BAR __builtin_amdgcn_s_barrier()
#define PG8_SCHED __builtin_amdgcn_sched_barrier(0)
    GUnit cur, nxt; int ui = 0;
    if (!S.next(0, cur)) return;
    unsigned offc[2][2], offn[2][2];
    if constexpr (GATHER) S.gather_offsets(cur, Rr, Cc, offc, RB);
    f32x4 acc[2][2][4][2];
#pragma unroll
    for (int a = 0; a < 2; ++a)
#pragma unroll
        for (int b = 0; b < 2; ++b)
#pragma unroll
            for (int m = 0; m < 4; ++m)
#pragma unroll
                for (int n = 0; n < 2; ++n) acc[a][b][m][n] = (f32x4){0.f, 0.f, 0.f, 0.f};
    bf16x8 At[4][2], B0[2][2], B1[2][2];
    v8i At8[4], B08[2], B18[2];
    const int f8scale = 0x7f7f7f7f;
    const char* cA = cur.A; const char* cB = cur.B;
    const char* nA = cA;
    PG8_STB(PG8_SB(0, 0), cB); PG8_STB(PG8_SB(0, 1), cB + hstep); PG8_STA(PG8_SA(0, 0), false, 0, 0); PG8_STA(PG8_SA(0, 1), false, 1, 0);
    if (wr == 1) PG8_BAR;
    PG8_WAIT_V(2); PG8_BAR;
    PG8_STB(PG8_SB(1, 0), cB + kstep); PG8_STA(PG8_SA(1, 0), false, 0, kstep); PG8_STB(PG8_SB(1, 1), cB + hstep + kstep);
    PG8_WAIT_V(6); PG8_BAR;
    cur.uc.par = 0;
    if constexpr (has_pf<Epi>::value) E.prefetch(cur.uc, cur.colbase, (unsigned char*)lds + 131072 + 12288, wid, lane);
    for (;;) {
        const bool has_next = S.next(ui + 1, nxt);
        cur.uc.par = ui & 1;
        if constexpr (GATHER) { if (has_next) S.gather_offsets(nxt, Rr, Cc, offn, RB); else {
#pragma unroll
            for (int h = 0; h < 2; ++h) { offn[h][0] = offc[h][0]; offn[h][1] = offc[h][1]; } } }
        nA = has_next ? nxt.A : cA; const char* nB = has_next ? nxt.B : cB;
        for (int t = 0; t < nt; t += 2) {
            const bool last = (t == nt - 2);
            const size_t k1 = (size_t)(t + 1) * kstep;
            const size_t k2 = last ? 0 : (size_t)(t + 2) * kstep, k3 = k2 + kstep;
            const char* b2 = (last ? nB : cB) + k2; const char* b3 = b2 + kstep;
            PG8_LDB(B0, 0, 0); PG8_LDB(B1, 0, 1); PG8_SCHED; PG8_LDA(At, 0, 0); PG8_STA(PG8_SA(1, 1), false, 1, k1);
            PG8_WAIT_V(8); PG8_WAIT_L(0); PG8_BAR; PG8_MMA(0, 0, At, B0); PG8_MMA(0, 1, At, B1); PG8_BAR; PG8_SCHED;
            PG8_LDA(At, 0, 1); PG8_STB(PG8_SB(0, 0), b2); PG8_STB(PG8_SB(0, 1), b2 + hstep); PG8_STA(PG8_SA(0, 0), last, 0, k2);
            PG8_WAIT_V(8); PG8_WAIT_L(0); PG8_BAR; PG8_MMA(1, 0, At, B0); PG8_MMA(1, 1, At, B1); PG8_BAR; PG8_SCHED;
            PG8_LDB(B0, 1, 0); PG8_LDB(B1, 1, 1); PG8_SCHED; PG8_LDA(At, 1, 0); PG8_STA(PG8_SA(0, 1), last, 1, k2);
            PG8_WAIT_V(8); PG8_WAIT_L(0); PG8_BAR; PG8_MMA(0, 0, At, B0); PG8_MMA(0, 1, At, B1); PG8_BAR; PG8_SCHED;
            PG8_LDA(At, 1, 1); PG8_STB(PG8_SB(1, 0), b3); PG8_STB(PG8_SB(1, 1), b3 + hstep); PG8_STA(PG8_SA(1, 0), last, 0, k3);
            PG8_WAIT_V(8); PG8_WAIT_L(0); PG8_BAR; PG8_MMA(1, 0, At, B0); PG8_MMA(1, 1, At, B1); PG8_BAR; PG8_SCHED;
        }
        if constexpr (F8) asm volatile("s_nop 15\n\ts_nop 7" ::: "memory");
        if (wr == 0) PG8_BAR;
        if constexpr (is_whole<Epi>::value) { E.whole(acc, cur.uc, cur.colbase, wr, wc, fr, fq, (float*)((unsigned char*)lds + 131072 + 8192)); }
        else {
        typename Epi::RowT rowv[2][4];
#pragma unroll
        for (int ai = 0; ai < 2; ++ai)
#pragma unroll
            for (int m = 0; m < 4; ++m) rowv[ai][m] = E.row_pre(cur.uc, ai * HALF + wr * 64 + m * 16 + fr);
#pragma unroll
        for (int ai = 0; ai < 2; ++ai)
#pragma unroll
            for (int m = 0; m < 4; ++m)
#pragma unroll
                for (int bj = 0; bj < 2; ++bj) E(cur.uc, ai * HALF + wr * 64 + m * 16 + fr, cur.colbase + bj * HALF + wc * 32, fq, acc[ai][bj][m][0], acc[ai][bj][m][1], rowv[ai][m]);
        }
        if (!has_next) break;
        if constexpr (has_pf<Epi>::value) { nxt.uc.par = (ui + 1) & 1; E.prefetch(nxt.uc, nxt.colbase, (unsigned char*)lds + 131072 + 12288, wid, lane); }
        if (!(has_chain<Epi>::value && cur.uc.e == 0))
#pragma unroll
        for (int a = 0; a < 2; ++a)
#pragma unroll
            for (int b = 0; b < 2; ++b)
#pragma unroll
                for (int m = 0; m < 4; ++m)
#pragma unroll
                    for (int n = 0; n < 2; ++n) acc[a][b][m][n] = (f32x4){0.f, 0.f, 0.f, 0.f};
        cur = nxt; cA = nA; cB = nB; ++ui;
        if constexpr (GATHER) {
#pragma unroll
            for (int h = 0; h < 2; ++h) { offc[h][0] = offn[h][0]; offc[h][1] = offn[h][1]; } }
        if (wr == 1) PG8_BAR;
    }
    PG8_WAIT_V(0);
    PG8_BAR;
#undef PG8_SA
#undef PG8_SB
#undef PG8_RAW
#undef PG8_STB
#undef PG8_STA
#undef PG8_LDA
#undef PG8_LDB
#undef PG8_MMA
#undef PG8_WAIT_V
#undef PG8_WAIT_L
#undef PG8_BAR
#undef PG8_SCHED
}
struct DenseSched { const void* A; const void* Bt; int RB; int pn0; StaticOrder so;
    __device__ __forceinline__ bool next(int i, GUnit& u) const { Unit t; if (!so.next(i, t)) return false;
        t.pn += pn0; u.A = (const char*)A + (size_t)t.pm * 256 * RB; u.B = (const char*)Bt + (size_t)t.pn * 256 * RB;
        u.uc.row0 = t.pm * 256; u.uc.e = 0; u.uc.idx0 = 0; u.uc.cnt = 0; u.uc.list = nullptr; u.colbase = t.pn * 256; return true; }
    __device__ __forceinline__ void gather_offsets(const GUnit&, const int (&)[2], const int (&)[2], unsigned (&)[2][2], int) const {}
};
struct ChainSched { const void* A0; const void* B0; const void* A1; const void* B1; int RB; StaticOrder so;
    __device__ __forceinline__ bool next(int i, GUnit& u) const { Unit t; if (!so.next(i >> 1, t)) return false; const int h = i & 1;
        u.A = (const char*)(h ? A1 : A0) + (size_t)t.pm * 256 * RB; u.B = (const char*)(h ? B1 : B0) + (size_t)t.pn * 256 * RB;
        u.uc.row0 = t.pm * 256; u.uc.e = h; u.uc.idx0 = 0; u.uc.cnt = 0; u.uc.list = nullptr; u.colbase = t.pn * 256; return true; }
    __device__ __forceinline__ void gather_offsets(const GUnit&, const int (&)[2], const int (&)[2], unsigned (&)[2][2], int) const {}
};
}
template <class Epi>
__device__ __forceinline__ void gemm_chain_fast(char* lds, const void* A0, const void* B0, const void* A1, const void* B1, int M, int N, int K, const Epi& E) {
    pg8::ChainSched S; S.A0 = A0; S.B0 = B0; S.A1 = A1; S.B1 = B1; S.RB = 2 * K; S.so.init(M / 256, N / 256, (int)gridDim.x, (int)blockIdx.x, WGM_DENSE);
    pg8::gemm_phase<Epi, pg8::ChainSched, false, false>((LAS unsigned char*)lds, K, S, E);
}
template <class Epi, bool F8 = false>
__device__ __forceinline__ void gemm_dense_fast(char* lds, const void* A, const void* Bt, int M, int N, int K, const Epi& E, int pn0 = 0) {
    pg8::DenseSched S; S.A = A; S.Bt = Bt; S.RB = F8 ? K : 2 * K; S.pn0 = pn0; S.so.init(M / 256, N / 256, (int)gridDim.x, (int)blockIdx.x, (N / 256 > 8) ? WGM_WIDE : WGM_DENSE);
    pg8::gemm_phase<Epi, pg8::DenseSched, false, F8>((LAS unsigned char*)lds, K, S, E);
}

struct NoRow {};
struct EpiNull { float* sink; typedef NoRow RowT;
    __device__ __forceinline__ NoRow row_pre(const UnitCtx&, int) const { return NoRow{}; }
    __device__ __forceinline__ void operator()(const UnitCtx& uc, int r, int cb, int fq, f32x4 v0, f32x4 v1, NoRow) const { if (v0[0] == 1.2345e-30f && v1[3] == 7.7e-31f) sink[0] = v0[1]; } };
struct EpiZ { bf16_t* Z; float* FL; const float* rstd; typedef float RowT;
    __device__ __forceinline__ float row_pre(const UnitCtx& uc, int r) const { return rstd[uc.row0 + r]; }
    __device__ __forceinline__ void operator()(const UnitCtx& uc, int r, int cb, int fq, f32x4 v0, f32x4 v1, float s) const {
        const int row = uc.row0 + r; v0 = v0 * s; v1 = v1 * s;
        bf16_t* zr = Z + (size_t)row * ZP + cb + 8 * fq;
        { const u32x2 a = pk4(v0), b = pk4(v1); *(u32x4*)zr = (u32x4){a.x, a.y, b.x, b.y}; }
        if (cb == OFF_FL && fq < 2) { float* f = FL + (size_t)row * 16 + 8 * fq; *(f32x4*)f = v0; *(f32x4*)(f + 4) = v1; }
    } };
struct EpiBf16 { bf16_t* O; int ldo; typedef NoRow RowT;
    __device__ __forceinline__ NoRow row_pre(const UnitCtx&, int) const { return NoRow{}; }
    __device__ __forceinline__ void operator()(const UnitCtx& uc, int r, int cb, int fq, f32x4 v0, f32x4 v1, NoRow) const {
        bf16_t* o = O + (size_t)(uc.row0 + r) * ldo + cb + 8 * fq; const u32x2 a = pk4(v0), b = pk4(v1); *(u32x4*)o = (u32x4){a.x, a.y, b.x, b.y};
    } };
struct EpiMixA { bf16_t* T; const bf16_t* Z; float sc; typedef NoRow RowT;
    __device__ __forceinline__ NoRow row_pre(const UnitCtx&, int) const { return NoRow{}; }
    __device__ __forceinline__ void operator()(const UnitCtx& uc, int r, int cb, int fq, f32x4 v0, f32x4 v1, NoRow) const {
        const int row = uc.row0 + r, c = cb + 8 * fq; const bf16_t* g = Z + (size_t)row * ZP + OFF_GM + c;
        const u32x4 gw = *(const u32x4*)g; const f32x4 g0 = unpk4((u32x2){gw.x, gw.y}), g1 = unpk4((u32x2){gw.z, gw.w}); f32x4 o0, o1;
#pragma unroll
        for (int j = 0; j < 4; ++j) { o0[j] = sigmoidf_(g0[j]) * v0[j] * sc; o1[j] = sigmoidf_(g1[j]) * v1[j] * sc; }
        bf16_t* t = T + (size_t)row * DM + c; { const u32x2 a = pk4(o0), b = pk4(o1); *(u32x4*)t = (u32x4){a.x, a.y, b.x, b.y}; }
    } };
struct EpiMixB { const bf16_t* T; const bf16_t* Z; unsigned char* MIXED; float sc; typedef NoRow RowT;
    __device__ __forceinline__ NoRow row_pre(const UnitCtx&, int) const { return NoRow{}; }
    __device__ __forceinline__ void operator()(const UnitCtx& uc, int r, int cb, int fq, f32x4 v0, f32x4 v1, NoRow) const {
        const int row = uc.row0 + r, c = cb + 8 * fq; const bf16_t* g = Z + (size_t)row * ZP + OFF_GF + c;
        const u32x4 gw = *(const u32x4*)g; const f32x4 g0 = unpk4((u32x2){gw.x, gw.y}), g1 = unpk4((u32x2){gw.z, gw.w}); const bf16_t* t = T + (size_t)row * DM + c;
        const u32x4 tw = *(const u32x4*)t; const f32x4 t0 = unpk4((u32x2){tw.x, tw.y}), t1 = unpk4((u32x2){tw.z, tw.w}); f32x4 o0, o1;
#pragma unroll
        for (int j = 0; j < 4; ++j) { o0[j] = (t0[j] + sigmoidf_(g0[j]) * v0[j] * sc); o1[j] = (t1[j] + sigmoidf_(g1[j]) * v1[j] * sc); }
        if (F8_P5) *(u32x2*)(MIXED + (size_t)row * DM + c) = (u32x2){pk4_fp8(o0 * F8_SX), pk4_fp8(o1 * F8_SX)};
        else { const u32x2 a = pk4(o0), b = pk4(o1); *(u32x4*)(MIXED + ((size_t)row * DM + c) * 2) = (u32x4){a.x, a.y, b.x, b.y}; }
    } };
struct EpiMixChain { static constexpr bool WHOLE = true; static constexpr bool CHAIN = true; typedef NoRow RowT; const bf16_t* Z; bf16_t* MIXED;
    __device__ __forceinline__ void whole(f32x4 (&acc)[2][2][4][2], const UnitCtx& uc, int colbase, int wr, int wc, int fr, int fq, float*) const {
        const bool first = uc.e == 0;
        u32x4 gq[2][2][2];
#define MIX_LD(i, slot) do { const int row_ = uc.row0 + ((i) >> 2) * 128 + wr * 64 + ((i) & 3) * 16 + fr; \
            _Pragma("unroll") for (int bj_ = 0; bj_ < 2; ++bj_) { const bf16_t* zp_ = Z + (size_t)row_ * ZP + colbase + bj_ * 128 + wc * 32 + 8 * fq; gq[slot][bj_][0] = *(const u32x4*)(zp_ + OFF_GF); if (first) gq[slot][bj_][1] = *(const u32x4*)(zp_ + OFF_GM); } } while (0)
        MIX_LD(0, 0);
#pragma unroll
        for (int i = 0; i < 8; ++i) { const int ai = i >> 2, m = i & 3; const int row = uc.row0 + ai * 128 + wr * 64 + m * 16 + fr;
            if (i + 1 < 8) MIX_LD(i + 1, (i + 1) & 1);
            __builtin_amdgcn_sched_barrier(0);
#pragma unroll
            for (int bj = 0; bj < 2; ++bj) { const u32x4 gw = gq[i & 1][bj][0]; const f32x4 f0 = unpk4((u32x2){gw.x, gw.y}), f1 = unpk4((u32x2){gw.z, gw.w});
                f32x4 d0, d1;
#pragma unroll
                for (int j = 0; j < 4; ++j) { d0[j] = 1.0f + __builtin_amdgcn_exp2f(-LOG2E * fmaxf(f0[j], -60.0f)); d1[j] = 1.0f + __builtin_amdgcn_exp2f(-LOG2E * fmaxf(f1[j], -60.0f)); }
                if (first) { const u32x4 mw = gq[i & 1][bj][1]; const f32x4 m0 = unpk4((u32x2){mw.x, mw.y}), m1 = unpk4((u32x2){mw.z, mw.w});
#pragma unroll
                    for (int j = 0; j < 4; ++j) { acc[ai][bj][m][0][j] *= sigmoidf_(m0[j]) * d0[j]; acc[ai][bj][m][1][j] *= sigmoidf_(m1[j]) * d1[j]; }
                } else { f32x4 o0, o1;
#pragma unroll
                    for (int j = 0; j < 4; ++j) { o0[j] = acc[ai][bj][m][0][j] * __builtin_amdgcn_rcpf(d0[j]); o1[j] = acc[ai][bj][m][1][j] * __builtin_amdgcn_rcpf(d1[j]); }
                    const u32x2 a = pk4(o0), b = pk4(o1); *(u32x4*)(MIXED + (size_t)row * DM + colbase + bj * 128 + wc * 32 + 8 * fq) = (u32x4){a.x, a.y, b.x, b.y}; } }
            __builtin_amdgcn_sched_barrier(0);
        }
#undef MIX_LD
    } };
struct EpiResid { const float* X; bf16_t* O; float sc; typedef NoRow RowT;
    __device__ __forceinline__ NoRow row_pre(const UnitCtx&, int) const { return NoRow{}; }
    __device__ __forceinline__ void operator()(const UnitCtx& uc, int r, int cb, int fq, f32x4 v0, f32x4 v1, NoRow) const {
        const size_t off = (size_t)(uc.row0 + r) * DM + cb + 8 * fq;
        const u32x2 a = pk4(*(const f32x4*)(X + off) + v0 * sc), b = pk4(*(const f32x4*)(X + off + 4) + v1 * sc); *(u32x4*)(O + off) = (u32x4){a.x, a.y, b.x, b.y};
    } };
struct EpiUp { bf16_t* H; const float* listr; const float* b_up; typedef float RowT;
    __device__ __forceinline__ float row_pre(const UnitCtx& uc, int r) const { const int idx = uc.idx0 + r; return (idx < uc.cnt) ? listr[(size_t)uc.e * NTOK + idx] : 0.f; }
    __device__ __forceinline__ void operator()(const UnitCtx& uc, int r, int cb, int fq, f32x4 v0, f32x4 v1, float rs) const {
        const int c = 16 * (cb >> 5) + 4 * fq; const float* bu = b_up + (size_t)uc.e * 2048 + c;
        const f32x4 bg = *(const f32x4*)bu, bb = *(const f32x4*)(bu + 1024); f32x4 o;
#pragma unroll
        for (int j = 0; j < 4; ++j) { float g = v0[j] * rs + bg[j], u = v1[j] * rs + bb[j]; g = fminf(g, 7.0f); u = fminf(fmaxf(u, -7.0f), 7.0f); o[j] = g * sigmoidf_(1.702f * g) * (u + 1.0f); }
        *(u32x2*)(H + (size_t)(uc.row0 + r) * EFF + c) = pk4(o);
    } };

struct EpiUpW { static constexpr bool WHOLE = true; static constexpr bool PF = true; typedef NoRow RowT; bf16_t* H; const float* listr; const float* b_up;
    __device__ __forceinline__ void prefetch(const UnitCtx& uc, int colbase, unsigned char* pf, int wid, int lane) const {
        asm volatile("" : "+v"(lane));
        LAS unsigned* dst = (LAS unsigned*)(pf + uc.par * 3072);
        if (wid == 0) __builtin_amdgcn_global_load_lds((const unsigned*)(listr + (size_t)uc.e * NTOK + uc.idx0 + lane * 4), dst, 16, 0, 0);
        else if (wid == 1) { const float* bp = b_up + (size_t)uc.e * 2048 + 128 * (colbase >> 8) + (lane & 31) * 4 + (lane >> 5) * 1024;
            __builtin_amdgcn_global_load_lds((const unsigned*)bp, (LAS unsigned*)(pf + uc.par * 3072 + 1024), 16, 0, 0); }
    }
    __device__ __forceinline__ void whole(f32x4 (&acc)[2][2][4][2], const UnitCtx& uc, int colbase, int wr, int wc, int fr, int fq, float* X) const {
        const int c = 128 * (colbase >> 8) + 32 * wc + 8 * fq; const float* pfb = X + 1024 + uc.par * 768; const float* bp = pfb + 256 + 32 * wc + 8 * fq - 0;
        float rs[2][4];
#pragma unroll
        for (int ai = 0; ai < 2; ++ai)
#pragma unroll
            for (int m = 0; m < 4; ++m) rs[ai][m] = pfb[ai * 128 + wr * 64 + m * 16 + fr];
        f32x4 bg0 = *(const f32x4*)bp, bg1 = *(const f32x4*)(bp + 4), bu0 = *(const f32x4*)(bp + 128), bu1 = *(const f32x4*)(bp + 132);
#pragma unroll
        for (int ai = 0; ai < 2; ++ai)
#pragma unroll
            for (int m = 0; m < 4; ++m) { const int idx = uc.idx0 + ai * 128 + wr * 64 + m * 16 + fr; rs[ai][m] = (idx < uc.cnt) ? rs[ai][m] * (1.0f / (F8_SX * F8_SW)) : 0.f; }
        bg0 *= F8_SH; bg1 *= F8_SH; bu0 += 1.0f; bu1 += 1.0f;
#pragma unroll
        for (int ai = 0; ai < 2; ++ai)
#pragma unroll
            for (int m = 0; m < 4; ++m) { const float r_ = rs[ai][m], r8 = r_ * F8_SH; f32x4 o[2];
#pragma unroll
                for (int n = 0; n < 2; ++n)
#pragma unroll
                    for (int j = 0; j < 4; ++j) { float g8 = acc[ai][0][m][n][j] * r8 + (n ? bg1[j] : bg0[j]), u1 = acc[ai][1][m][n][j] * r_ + (n ? bu1[j] : bu0[j]);
                        g8 = fminf(g8, 7.0f * F8_SH); u1 = __builtin_amdgcn_fmed3f(u1, -6.0f, 8.0f);
                        o[n][j] = g8 * __builtin_amdgcn_rcpf(1.0f + __builtin_amdgcn_exp2f(g8 * (-1.702f * LOG2E / F8_SH))) * u1; }
                *(u32x2*)((unsigned char*)H + (size_t)(uc.row0 + ai * 128 + wr * 64 + m * 16 + fr) * EFF + c) = (u32x2){pk4_fp8(o[0]), pk4_fp8(o[1])}; }
    } };
struct EpiDownW { static constexpr bool WHOLE = true; static constexpr bool PF = true; typedef NoRow RowT; bf16_t* Y; const float* listg; const float* b_down;
    __device__ __forceinline__ void prefetch(const UnitCtx& uc, int colbase, unsigned char* pf, int wid, int lane) const {
        asm volatile("" : "+v"(lane));
        unsigned char* d = pf + uc.par * 3072;
        if (wid == 0) __builtin_amdgcn_global_load_lds((const unsigned*)(uc.list + uc.idx0 + lane * 4), (LAS unsigned*)d, 16, 0, 0);
        else if (wid == 1) __builtin_amdgcn_global_load_lds((const unsigned*)(listg + (size_t)uc.e * NTOK + uc.idx0 + lane * 4), (LAS unsigned*)(d + 1024), 16, 0, 0);
        else if (wid == 2) __builtin_amdgcn_global_load_lds((const unsigned*)(b_down + (size_t)uc.e * 1024 + colbase + lane * 4), (LAS unsigned*)(d + 2048), 16, 0, 0);
    }
    __device__ __forceinline__ void whole(f32x4 (&acc)[2][2][4][2], const UnitCtx& uc, int colbase, int wr, int wc, int fr, int fq, float* X) const {
        const float* pfb = X + 1024 + uc.par * 768; const int* pfi = (const int*)pfb;
        int aid[2][4]; float gt[2][4];
#pragma unroll
        for (int ai = 0; ai < 2; ++ai)
#pragma unroll
            for (int m = 0; m < 4; ++m) { const int ri = ai * 128 + wr * 64 + m * 16 + fr; aid[ai][m] = pfi[ri]; gt[ai][m] = pfb[256 + ri]; }
        f32x4 bd[2][2];
#pragma unroll
        for (int bj = 0; bj < 2; ++bj) { const float* bp = pfb + 512 + 128 * bj + 32 * wc + 8 * fq; bd[bj][0] = *(const f32x4*)bp; bd[bj][1] = *(const f32x4*)(bp + 4); }
#pragma unroll
        for (int ai = 0; ai < 2; ++ai)
#pragma unroll
            for (int m = 0; m < 4; ++m) { asm volatile("" : "+v"(aid[ai][m]), "+v"(gt[ai][m])); const int idx = uc.idx0 + ai * 128 + wr * 64 + m * 16 + fr; if (!(idx < uc.cnt)) { aid[ai][m] = -1; gt[ai][m] = 0.f; } }
#pragma unroll
        for (int ai = 0; ai < 2; ++ai)
#pragma unroll
            for (int m = 0; m < 4; ++m) { if (aid[ai][m] < 0) continue; const float g = gt[ai][m]; bf16_t* y = Y + (size_t)aid[ai][m] * DM + colbase + 32 * wc + 8 * fq;
#pragma unroll
                for (int bj = 0; bj < 2; ++bj) { const u32x2 a = pk4((acc[ai][bj][m][0] * (1.0f / (F8_SH * F8_SW)) + bd[bj][0]) * g), b = pk4((acc[ai][bj][m][1] * (1.0f / (F8_SH * F8_SW)) + bd[bj][1]) * g); *(u32x4*)(y + 128 * bj) = (u32x4){a.x, a.y, b.x, b.y}; } }
    } };

struct EpiKVHead { static constexpr bool WHOLE = true; typedef NoRow RowT; bf16_t* KVM; const float* gkn; unsigned char* K8;
    __device__ __forceinline__ void whole(f32x4 (&acc)[2][2][4][2], const UnitCtx& uc, int colbase, int wr, int wc, int fr, int fq, float* X) const {
        if (wc < 2) {
#pragma unroll
            for (int ai = 0; ai < 2; ++ai)
#pragma unroll
                for (int m = 0; m < 4; ++m) { float ss = 0.f;
#pragma unroll
                    for (int bj = 0; bj < 2; ++bj)
#pragma unroll
                        for (int n = 0; n < 2; ++n) { const f32x4 v = acc[ai][bj][m][n]; ss += (v[0] * v[0] + v[1] * v[1]) + (v[2] * v[2] + v[3] * v[3]); }
                    ss += __shfl_xor(ss, 16); ss += __shfl_xor(ss, 32);
                    if (fq == 0) X[(ai * 128 + wr * 64 + m * 16 + fr) * 4 + wc] = ss; }
        }
        asm volatile("s_waitcnt lgkmcnt(0)" ::: "memory"); __builtin_amdgcn_s_barrier(); asm volatile("" ::: "memory");
        f32x4 gv[2][2];
#pragma unroll
        for (int bj = 0; bj < 2; ++bj) { const int c = 64 * (wc & 1) + 32 * bj + 8 * fq; gv[bj][0] = *(const f32x4*)(gkn + c); gv[bj][1] = *(const f32x4*)(gkn + c + 4); }
#pragma unroll
        for (int ai = 0; ai < 2; ++ai)
#pragma unroll
            for (int m = 0; m < 4; ++m) { const int r = ai * 128 + wr * 64 + m * 16 + fr; float rs = 1.f;
                if (wc < 2) rs = __builtin_amdgcn_rsqf((X[r * 4] + X[r * 4 + 1]) * (1.0f / 128.0f) + EPS);
#pragma unroll
                for (int bj = 0; bj < 2; ++bj) { const int c = 64 * wc + 32 * bj + 8 * fq; f32x4 v0 = acc[ai][bj][m][0] * rs, v1 = acc[ai][bj][m][1] * rs;
                    if (wc < 2) { v0 = v0 * gv[bj][0]; v1 = v1 * gv[bj][1]; }
                    if (ATT_F8 && wc < 2) *(u32x2*)(K8 + (size_t)(uc.row0 + r) * 1024 + (colbase >> 1) + c) = (u32x2){pk4_fp8(v0 * 16.0f), pk4_fp8(v1 * 16.0f)};
                    else { const u32x2 a = pk4(v0), b = pk4(v1); *(u32x4*)(KVM + (size_t)(uc.row0 + r) * 2048 + colbase + c) = (u32x4){a.x, a.y, b.x, b.y}; } } }
    } };
struct EpiQHead { static constexpr bool WHOLE = true; typedef NoRow RowT; bf16_t* QM; const float* gqn; const float* gqr; const f32x2* rope; unsigned char* QM8;
    __device__ __forceinline__ void whole(f32x4 (&acc)[2][2][4][2], const UnitCtx& uc, int colbase, int wr, int wc, int fr, int fq, float* X) const {
        const int h = colbase >> 8;
        if (wc < 3) {
#pragma unroll
            for (int ai = 0; ai < 2; ++ai)
#pragma unroll
                for (int m = 0; m < 4; ++m) { float ss = 0.f;
#pragma unroll
                    for (int bj = 0; bj < 2; ++bj)
#pragma unroll
                        for (int n = 0; n < 2; ++n) { const f32x4 v = acc[ai][bj][m][n]; ss += (v[0] * v[0] + v[1] * v[1]) + (v[2] * v[2] + v[3] * v[3]); }
                    ss += __shfl_xor(ss, 16); ss += __shfl_xor(ss, 32);
                    if (fq == 0) X[(ai * 128 + wr * 64 + m * 16 + fr) * 4 + wc] = ss; }
        }
        asm volatile("s_waitcnt lgkmcnt(0)" ::: "memory"); __builtin_amdgcn_s_barrier(); asm volatile("" ::: "memory");
        if (wc == 3) return;
#pragma unroll
        for (int ai = 0; ai < 2; ++ai)
#pragma unroll
            for (int m = 0; m < 4; ++m) { const int r = ai * 128 + wr * 64 + m * 16 + fr; const int row = uc.row0 + r;
                bf16_t* qrow = QM + (size_t)row * 1536 + h * 192;
                if (wc < 2) { const float rs = C2_MLA * __builtin_amdgcn_rsqf((X[r * 4] + X[r * 4 + 1]) * (1.0f / 128.0f) + EPS);
#pragma unroll
                    for (int bj = 0; bj < 2; ++bj) { const int c = 64 * wc + 32 * bj + 8 * fq;
                        const f32x4 v0 = acc[ai][bj][m][0] * rs * *(const f32x4*)(gqn + c), v1 = acc[ai][bj][m][1] * rs * *(const f32x4*)(gqn + c + 4);
                        if (ATT_F8) *(u32x2*)(QM8 + (size_t)row * 1536 + h * 192 + c) = (u32x2){pk4_fp8(v0 * 64.0f), pk4_fp8(v1 * 64.0f)};
                        else { const u32x2 a = pk4(v0), b = pk4(v1); *(u32x4*)(qrow + c) = (u32x4){a.x, a.y, b.x, b.y}; } }
                } else { const float rs = C2_MLA * __builtin_amdgcn_rsqf(X[r * 4 + 2] * (1.0f / 64.0f) + EPS); const int pos = row & (SEQ - 1); const f32x2* rt = rope + (size_t)pos * 32 + 8 * fq;
                    f32x4 o1[2], o2[2];
#pragma unroll
                    for (int n = 0; n < 2; ++n) { const f32x4 g1 = *(const f32x4*)(gqr + 8 * fq + 4 * n), g2 = *(const f32x4*)(gqr + 32 + 8 * fq + 4 * n);
#pragma unroll
                        for (int j = 0; j < 4; ++j) { const float y1 = acc[ai][0][m][n][j] * rs * g1[j], y2 = acc[ai][1][m][n][j] * rs * g2[j]; const f32x2 cs = rt[4 * n + j];
                            o1[n][j] = y1 * cs.x - y2 * cs.y; o2[n][j] = y2 * cs.x + y1 * cs.y; } }
                    if (ATT_F8) { unsigned char* q8 = QM8 + (size_t)row * 1536 + h * 192; *(u32x2*)(q8 + 128 + 8 * fq) = (u32x2){pk4_fp8(o1[0] * 64.0f), pk4_fp8(o1[1] * 64.0f)}; *(u32x2*)(q8 + 160 + 8 * fq) = (u32x2){pk4_fp8(o2[0] * 64.0f), pk4_fp8(o2[1] * 64.0f)}; }
                    else {
                    { const u32x2 a = pk4(o1[0]), b = pk4(o1[1]); *(u32x4*)(qrow + 128 + 8 * fq) = (u32x4){a.x, a.y, b.x, b.y}; }
                    { const u32x2 a = pk4(o2[0]), b = pk4(o2[1]); *(u32x4*)(qrow + 160 + 8 * fq) = (u32x4){a.x, a.y, b.x, b.y}; } } } }
    } };

struct EpiZHead { static constexpr bool WHOLE = true; static constexpr bool PF = true; typedef NoRow RowT;
    bf16_t* Z; bf16_t* CQN; bf16_t* CKVN; bf16_t* KR; unsigned char* KR8; unsigned char* FQ8; unsigned char* FK8; float* LF; const float* rstd; const float* gkr; const float* gfq; const float* gfk; const float* fbias; const f32x2* rope;
    __device__ __forceinline__ void prefetch(const UnitCtx& uc, int colbase, unsigned char* pf, int wid, int lane) const {
        asm volatile("" : "+v"(lane));
        if (wid == 0) __builtin_amdgcn_global_load_lds((const unsigned*)(rstd + uc.row0 + lane * 4), (LAS unsigned*)(pf + uc.par * 3072), 16, 0, 0);
    }
    __device__ __forceinline__ void whole(f32x4 (&acc)[2][2][4][2], const UnitCtx& uc, int colbase, int wr, int wc, int fr, int fq, float* X) const {
        const int pn = colbase >> 8; const float* pfb = X + 1024 + uc.par * 768;
        float s1[2][4];
#pragma unroll
        for (int ai = 0; ai < 2; ++ai)
#pragma unroll
            for (int m = 0; m < 4; ++m) s1[ai][m] = pfb[ai * 128 + wr * 64 + m * 16 + fr] * ((F8_P1 && pn >= P1_F8_TILE0) ? 1.0f / (F8_SX * F8_SW) : 1.0f);
        if (pn < 2) {
#pragma unroll
            for (int ai = 0; ai < 2; ++ai)
#pragma unroll
                for (int m = 0; m < 4; ++m) { float ss = 0.f;
#pragma unroll
                    for (int bj = 0; bj < 2; ++bj)
#pragma unroll
                        for (int n = 0; n < 2; ++n) { const f32x4 v = acc[ai][bj][m][n]; ss += (v[0] * v[0] + v[1] * v[1]) + (v[2] * v[2] + v[3] * v[3]); }
                    ss += __shfl_xor(ss, 16); ss += __shfl_xor(ss, 32);
                    if (fq == 0) X[(ai * 128 + wr * 64 + m * 16 + fr) * 4 + wc] = ss; }
            asm volatile("s_waitcnt lgkmcnt(0)" ::: "memory"); __builtin_amdgcn_s_barrier(); asm volatile("" ::: "memory");
            bf16_t* O = pn ? CKVN : CQN;
#pragma unroll
            for (int ai = 0; ai < 2; ++ai)
#pragma unroll
                for (int m = 0; m < 4; ++m) { const int r = ai * 128 + wr * 64 + m * 16 + fr; const float s = s1[ai][m];
                    const float tot = (X[r * 4] + X[r * 4 + 1]) + (X[r * 4 + 2] + X[r * 4 + 3]); const float rn = s * __builtin_amdgcn_rsqf(s * s * tot * (1.0f / 256.0f) + EPS);
#pragma unroll
                    for (int bj = 0; bj < 2; ++bj) { const int c = 64 * wc + 32 * bj + 8 * fq; const u32x2 a = pk4(acc[ai][bj][m][0] * rn), b = pk4(acc[ai][bj][m][1] * rn);
                        *(u32x4*)(O + (size_t)(uc.row0 + r) * 256 + c) = (u32x4){a.x, a.y, b.x, b.y}; } }
            return;
        }
        const int G = (colbase >> 6) + wc, gc = 64 * G;
        if (G >= 8 && G < 41) {
#pragma unroll
            for (int ai = 0; ai < 2; ++ai)
#pragma unroll
                for (int m = 0; m < 4; ++m) { const int row = uc.row0 + ai * 128 + wr * 64 + m * 16 + fr; const float s = s1[ai][m]; float ss = 0.f;
#pragma unroll
                    for (int bj = 0; bj < 2; ++bj)
#pragma unroll
                        for (int n = 0; n < 2; ++n) { const f32x4 v = acc[ai][bj][m][n]; ss += (v[0] * v[0] + v[1] * v[1]) + (v[2] * v[2] + v[3] * v[3]); }
                    ss += __shfl_xor(ss, 16); ss += __shfl_xor(ss, 32);
                    const float rn = s * __builtin_amdgcn_rsqf(s * s * ss * (1.0f / 64.0f) + EPS);
                    if (G == 8) { const int pos = row & (SEQ - 1); const f32x2* rt = rope + (size_t)pos * 32 + 8 * fq; f32x4 o1[2], o2[2];
#pragma unroll
                        for (int n = 0; n < 2; ++n) { const f32x4 g1 = *(const f32x4*)(gkr + 8 * fq + 4 * n), g2 = *(const f32x4*)(gkr + 32 + 8 * fq + 4 * n);
#pragma unroll
                            for (int j = 0; j < 4; ++j) { const float y1 = acc[ai][0][m][n][j] * rn * g1[j], y2 = acc[ai][1][m][n][j] * rn * g2[j]; const f32x2 cs = rt[4 * n + j];
                                o1[n][j] = y1 * cs.x - y2 * cs.y; o2[n][j] = y2 * cs.x + y1 * cs.y; } }
                        if (ATT_F8) { *(u32x2*)(KR8 + (size_t)row * 64 + 8 * fq) = (u32x2){pk4_fp8(o1[0] * 16.0f), pk4_fp8(o1[1] * 16.0f)}; *(u32x2*)(KR8 + (size_t)row * 64 + 32 + 8 * fq) = (u32x2){pk4_fp8(o2[0] * 16.0f), pk4_fp8(o2[1] * 16.0f)}; }
                        else {
                        { const u32x2 a = pk4(o1[0]), b = pk4(o1[1]); *(u32x4*)(KR + (size_t)row * 64 + 8 * fq) = (u32x4){a.x, a.y, b.x, b.y}; }
                        { const u32x2 a = pk4(o2[0]), b = pk4(o2[1]); *(u32x4*)(KR + (size_t)row * 64 + 32 + 8 * fq) = (u32x4){a.x, a.y, b.x, b.y}; } }
                    } else { const bool isq = G < 25; const float* gp = isq ? gfq : gfk; const float rq = isq ? rn * C2_FOX : rn;
#pragma unroll
                        for (int bj = 0; bj < 2; ++bj) { const int c = 32 * bj + 8 * fq; const f32x4 v0 = acc[ai][bj][m][0] * rq * *(const f32x4*)(gp + c), v1 = acc[ai][bj][m][1] * rq * *(const f32x4*)(gp + c + 4);
                            if (ATT_F8) { unsigned char* d8 = (isq ? FQ8 + (size_t)row * 1024 + (G - 9) * 64 : FK8 + (size_t)row * 1024 + (G - 25) * 64) + c; const float s8 = isq ? 64.0f : 16.0f;
                                *(u32x2*)d8 = (u32x2){pk4_fp8(v0 * s8), pk4_fp8(v1 * s8)}; }
                            else { const u32x2 a = pk4(v0), b = pk4(v1); *(u32x4*)(Z + (size_t)row * ZP + gc + c) = (u32x4){a.x, a.y, b.x, b.y}; } } } }
            return;
        }
#pragma unroll
        for (int ai = 0; ai < 2; ++ai)
#pragma unroll
            for (int m = 0; m < 4; ++m) { const int row = uc.row0 + ai * 128 + wr * 64 + m * 16 + fr; const float s = s1[ai][m];
#pragma unroll
                for (int bj = 0; bj < 2; ++bj) { const int c = 32 * bj + 8 * fq; const f32x4 v0 = acc[ai][bj][m][0] * s, v1 = acc[ai][bj][m][1] * s;
                    if (G == 57 && bj == 0 && fq < 2) { const f32x4 b0 = *(const f32x4*)(fbias + 8 * fq), b1 = *(const f32x4*)(fbias + 8 * fq + 4); f32x4 l0, l1;
#pragma unroll
                        for (int j = 0; j < 4; ++j) { const float x0 = v0[j] + b0[j], x1 = v1[j] + b1[j]; l0[j] = fminf(x0, 0.f) - log1pf(__expf(-fabsf(x0))); l1[j] = fminf(x1, 0.f) - log1pf(__expf(-fabsf(x1))); }
                        float* lf = LF + (size_t)row * 16 + 8 * fq; *(f32x4*)lf = l0; *(f32x4*)(lf + 4) = l1; }
                    const u32x2 a = pk4(v0), b = pk4(v1); *(u32x4*)(Z + (size_t)row * ZP + gc + c) = (u32x4){a.x, a.y, b.x, b.y}; } }
    } };
struct AidGate { int aid; float g; };
struct EpiDown { bf16_t* Y; const float* gate; const float* b_down; typedef AidGate RowT;
    __device__ __forceinline__ AidGate row_pre(const UnitCtx& uc, int r) const { const int idx = uc.idx0 + r; AidGate q; const bool ok = idx < uc.cnt; q.aid = ok ? uc.list[idx] : -1; q.g = ok ? gate[(size_t)uc.e * NTOK + idx] : 0.f; return q; }
    __device__ __forceinline__ void operator()(const UnitCtx& uc, int r, int cb, int fq, f32x4 v0, f32x4 v1, AidGate ag) const {
        if (ag.aid < 0) return;
        const int aid = ag.aid; const float g = ag.g; const int c = cb + 8 * fq; const float* bd = b_down + (size_t)uc.e * 1024 + c;
        const f32x4 o0 = (v0 + *(const f32x4*)bd) * g, o1 = (v1 + *(const f32x4*)(bd + 4)) * g;
        bf16_t* y = Y + (size_t)aid * DM + c; { const u32x2 a = pk4(o0), b = pk4(o1); *(u32x4*)y = (u32x4){a.x, a.y, b.x, b.y}; }
    } };
struct EpiF32 { bf16_t* T; typedef NoRow RowT;
    __device__ __forceinline__ NoRow row_pre(const UnitCtx&, int) const { return NoRow{}; }
    __device__ __forceinline__ void operator()(const UnitCtx& uc, int r, int cb, int fq, f32x4 v0, f32x4 v1, NoRow) const {
        bf16_t* t = T + (size_t)(uc.row0 + r) * DM + cb + 8 * fq; const u32x2 a = pk4(v0), b = pk4(v1); *(u32x4*)t = (u32x4){a.x, a.y, b.x, b.y};
    } };
struct EpiPle { float* O; const bf16_t* X2; const bf16_t* T; const float* rstd3; typedef float RowT;
    __device__ __forceinline__ float row_pre(const UnitCtx& uc, int r) const { return rstd3[uc.row0 + r] * (F8_PLE ? 1.0f / (F8_SX * F8_SW) : 1.0f); }
    __device__ __forceinline__ void operator()(const UnitCtx& uc, int r, int cb, int fq, f32x4 v0, f32x4 v1, float rs) const {
        const int row = uc.row0 + r; const size_t off = (size_t)row * DM + cb + 8 * fq;
        const u32x4 tw = *(const u32x4*)(T + off), xw = *(const u32x4*)(X2 + off); const f32x4 t0 = unpk4((u32x2){tw.x, tw.y}), t1 = unpk4((u32x2){tw.z, tw.w}); f32x4 x0 = unpk4((u32x2){xw.x, xw.y}), x1 = unpk4((u32x2){xw.z, xw.w});
#pragma unroll
        for (int j = 0; j < 4; ++j) { x0[j] += sigmoidf_(rs * v0[j]) * t0[j]; x1[j] += sigmoidf_(rs * v1[j]) * t1[j]; }
        *(f32x4*)(O + off) = x0; *(f32x4*)(O + off + 4) = x1;
    } };

__device__ __forceinline__ void phase_post1(const Args& a, int gw, int ngw, int lane) {
    unsigned char* ws = a.ws; bf16_t* Z = (bf16_t*)(ws + WS_Z); bf16_t* CQN = (bf16_t*)(ws + WS_CQN); bf16_t* CKVN = (bf16_t*)(ws + WS_CKVN); bf16_t* KR = (bf16_t*)(ws + WS_KR);
    const float* FL = (const float*)(ws + WS_FL); float* LF = (float*)(ws + WS_LF);
    const float* g_kr = a.in[11]; const float* g_fq = a.in[12]; const float* g_fk = a.in[13]; const float* fbias = a.in[14];
    const float gkr = g_kr[lane];
    float gq[16], gk[16];
#pragma unroll
    for (int j = 0; j < 16; ++j) { gq[j] = g_fq[(lane & 3) * 16 + j] * C2_FOX; gk[j] = g_fk[(lane & 3) * 16 + j]; }
    for (int m = gw; m < NTOK; m += ngw) {
        bf16_t* zr = Z + (size_t)m * ZP; const int pos = m & (SEQ - 1);
#pragma unroll
        for (int w = 0; w < 2; ++w) {
            const f32x4 v = unpk4(*((const u32x2*)(zr + (w ? OFF_CKV : OFF_CQ)) + lane));
            const float ss = wave_sum((v[0] * v[0] + v[1] * v[1]) + (v[2] * v[2] + v[3] * v[3]));
            const float rs = __builtin_amdgcn_rsqf(ss * (1.0f / 256.0f) + EPS);
            *((u32x2*)((w ? CKVN : CQN) + (size_t)m * 256) + lane) = pk4(v * rs);
        }
        {
            const float v = bf2f(zr[OFF_KR + lane]); const float ss = wave_sum(v * v); const float rs = __builtin_amdgcn_rsqf(ss * (1.0f / 64.0f) + EPS);
            const float y = v * rs * gkr; const float other = __shfl_xor(y, 32);
            float c, s; rope_cs(pos, lane & 31, c, s);
            const float o = (lane < 32) ? (y * c - other * s) : (y * c + other * s);
            KR[(size_t)m * 64 + lane] = (bf16_t)f2bf(o);
        }
#pragma unroll
        for (int w = 0; w < 2; ++w) {
            bf16_t* p = zr + (w ? OFF_FK : OFF_FQ) + lane * 16;
            const u32x4 r0 = *(const u32x4*)p, r1 = *(const u32x4*)(p + 8); float v[16];
            v[0] = bf2f(r0.x & 0xffffu); v[1] = bf2f(r0.x >> 16); v[2] = bf2f(r0.y & 0xffffu); v[3] = bf2f(r0.y >> 16); v[4] = bf2f(r0.z & 0xffffu); v[5] = bf2f(r0.z >> 16); v[6] = bf2f(r0.w & 0xffffu); v[7] = bf2f(r0.w >> 16);
            v[8] = bf2f(r1.x & 0xffffu); v[9] = bf2f(r1.x >> 16); v[10] = bf2f(r1.y & 0xffffu); v[11] = bf2f(r1.y >> 16); v[12] = bf2f(r1.z & 0xffffu); v[13] = bf2f(r1.z >> 16); v[14] = bf2f(r1.w & 0xffffu); v[15] = bf2f(r1.w >> 16);
            float ss = 0.f;
#pragma unroll
            for (int j = 0; j < 16; ++j) ss += v[j] * v[j];
            ss += __shfl_xor(ss, 1); ss += __shfl_xor(ss, 2);
            const float rs = __builtin_amdgcn_rsqf(ss * (1.0f / 64.0f) + EPS);
            u32x4 o0, o1;
#define PP(i) pk2(v[i] * rs * (w ? gk[i] : gq[i]), v[i + 1] * rs * (w ? gk[i + 1] : gq[i + 1]))
            o0.x = PP(0); o0.y = PP(2); o0.z = PP(4); o0.w = PP(6); o1.x = PP(8); o1.y = PP(10); o1.z = PP(12); o1.w = PP(14);
#undef PP
            *(u32x4*)p = o0; *(u32x4*)(p + 8) = o1;
        }
        if (lane < 16) { const float xv = FL[(size_t)m * 16 + lane] + fbias[lane]; LF[(size_t)m * 16 + lane] = fminf(xv, 0.f) - log1pf(__expf(-fabsf(xv))); }
    }
}
__device__ __forceinline__ void phase_scan(const Args& a, char* lds, int wave, int lane) {
    const float* LF = (const float*)(a.ws + WS_LF); float* FC = (float*)(a.ws + WS_FC); float* wt = (float*)(lds + 131072 + 12288);
    for (int it = blockIdx.x; it < BATCH * 16; it += gridDim.x) {
        const int b = it >> 4, h = it & 15, t = wave * 64 + lane; const float* src = LF + ((size_t)b * SEQ + (size_t)t * 16) * 16 + h;
        float v[16];
#pragma unroll
        for (int i = 0; i < 16; ++i) v[i] = src[(size_t)i * 16];
#pragma unroll
        for (int i = 1; i < 16; ++i) v[i] += v[i - 1];
        float incl = v[15];
#pragma unroll
        for (int o = 1; o < 64; o <<= 1) { const float u = __shfl_up(incl, o); if (lane >= o) incl += u; }
        if (lane == 63) wt[wave] = incl;
        __syncthreads();
        float base = incl - v[15];
        for (int w = 0; w < wave; ++w) base += wt[w];
        float* dst = FC + ((size_t)b * 16 + h) * SEQ + t * 16;
#pragma unroll
        for (int i = 0; i < 16; i += 4) *(f32x4*)(dst + i) = (f32x4){(base + v[i]) * LOG2E, (base + v[i + 1]) * LOG2E, (base + v[i + 2]) * LOG2E, (base + v[i + 3]) * LOG2E};
#if FOX_BIAS_MFMA
        u32x4* rec = (u32x4*)(a.ws + WS_FCR) + ((size_t)b * 16 + h) * SEQ + t * 16;
#pragma unroll
        for (int i = 0; i < 16; ++i) { const float x = (base + v[i]) * LOG2E; const unsigned b1 = f2bf(x); const float r1 = x - bf2f(b1); const unsigned b2 = f2bf(r1); const unsigned b3 = f2bf(r1 - bf2f(b2));
            rec[i] = (u32x4){0x3f803f80u, 0x3f80u | (b1 << 16), b2 | (b3 << 16), 0u}; }
#endif
        __syncthreads();
    }
}
__device__ __forceinline__ void phase_post2(const Args& a, int gw, int ngw, int lane) {
    unsigned char* ws = a.ws; bf16_t* QM = (bf16_t*)(ws + WS_QM); bf16_t* KVM = (bf16_t*)(ws + WS_KVM);
    const float* g_qn = a.in[8]; const float* g_qr = a.in[9]; const float* g_kn = a.in[10];
    const int sub = lane & 7;
    float gn[16], gr[8], gkn[16];
#pragma unroll
    for (int j = 0; j < 16; ++j) { gn[j] = g_qn[sub * 16 + j] * C2_MLA; gkn[j] = g_kn[sub * 16 + j]; }
#pragma unroll
    for (int j = 0; j < 8; ++j) gr[j] = g_qr[sub * 8 + j] * C2_MLA;
    for (int m = gw; m < NTOK; m += ngw) {
        const int pos = m & (SEQ - 1);
        bf16_t* qh = QM + (size_t)m * 1536 + (lane >> 3) * 192;
        {
            bf16_t* p = qh + sub * 16; const u32x4 r0 = *(const u32x4*)p, r1 = *(const u32x4*)(p + 8); float v[16];
            v[0] = bf2f(r0.x & 0xffffu); v[1] = bf2f(r0.x >> 16); v[2] = bf2f(r0.y & 0xffffu); v[3] = bf2f(r0.y >> 16); v[4] = bf2f(r0.z & 0xffffu); v[5] = bf2f(r0.z >> 16); v[6] = bf2f(r0.w & 0xffffu); v[7] = bf2f(r0.w >> 16);
            v[8] = bf2f(r1.x & 0xffffu); v[9] = bf2f(r1.x >> 16); v[10] = bf2f(r1.y & 0xffffu); v[11] = bf2f(r1.y >> 16); v[12] = bf2f(r1.z & 0xffffu); v[13] = bf2f(r1.z >> 16); v[14] = bf2f(r1.w & 0xffffu); v[15] = bf2f(r1.w >> 16);
            float ss = 0.f;
#pragma unroll
            for (int j = 0; j < 16; ++j) ss += v[j] * v[j];
            ss += __shfl_xor(ss, 1); ss += __shfl_xor(ss, 2); ss += __shfl_xor(ss, 4);
            const float rs = __builtin_amdgcn_rsqf(ss * (1.0f / 128.0f) + EPS);
            u32x4 o0, o1;
#define PP(i) pk2(v[i] * rs * gn[i], v[i + 1] * rs * gn[i + 1])
            o0.x = PP(0); o0.y = PP(2); o0.z = PP(4); o0.w = PP(6); o1.x = PP(8); o1.y = PP(10); o1.z = PP(12); o1.w = PP(14);
#undef PP
            *(u32x4*)p = o0; *(u32x4*)(p + 8) = o1;
        }
        {
            bf16_t* p = qh + 128 + sub * 8; const u32x4 r0 = *(const u32x4*)p; float v[8];
            v[0] = bf2f(r0.x & 0xffffu); v[1] = bf2f(r0.x >> 16); v[2] = bf2f(r0.y & 0xffffu); v[3] = bf2f(r0.y >> 16); v[4] = bf2f(r0.z & 0xffffu); v[5] = bf2f(r0.z >> 16); v[6] = bf2f(r0.w & 0xffffu); v[7] = bf2f(r0.w >> 16);
            float ss = 0.f;
#pragma unroll
            for (int j = 0; j < 8; ++j) ss += v[j] * v[j];
            ss += __shfl_xor(ss, 1); ss += __shfl_xor(ss, 2); ss += __shfl_xor(ss, 4);
            const float rs = __builtin_amdgcn_rsqf(ss * (1.0f / 64.0f) + EPS); float o[8];
#pragma unroll
            for (int j = 0; j < 8; ++j) { const float y = v[j] * rs * gr[j]; const float other = __shfl_xor(y, 4); float c, s; rope_cs(pos, (sub & 3) * 8 + j, c, s);
                o[j] = (sub < 4) ? (y * c - other * s) : (y * c + other * s); }
            u32x4 w; w.x = pk2(o[0], o[1]); w.y = pk2(o[2], o[3]); w.z = pk2(o[4], o[5]); w.w = pk2(o[6], o[7]); *(u32x4*)p = w;
        }
        {
            bf16_t* p = KVM + (size_t)m * 2048 + (lane >> 3) * 256 + sub * 16; const u32x4 r0 = *(const u32x4*)p, r1 = *(const u32x4*)(p + 8); float v[16];
            v[0] = bf2f(r0.x & 0xffffu); v[1] = bf2f(r0.x >> 16); v[2] = bf2f(r0.y & 0xffffu); v[3] = bf2f(r0.y >> 16); v[4] = bf2f(r0.z & 0xffffu); v[5] = bf2f(r0.z >> 16); v[6] = bf2f(r0.w & 0xffffu); v[7] = bf2f(r0.w >> 16);
            v[8] = bf2f(r1.x & 0xffffu); v[9] = bf2f(r1.x >> 16); v[10] = bf2f(r1.y & 0xffffu); v[11] = bf2f(r1.y >> 16); v[12] = bf2f(r1.z & 0xffffu); v[13] = bf2f(r1.z >> 16); v[14] = bf2f(r1.w & 0xffffu); v[15] = bf2f(r1.w >> 16);
            float ss = 0.f;
#pragma unroll
            for (int j = 0; j < 16; ++j) ss += v[j] * v[j];
            ss += __shfl_xor(ss, 1); ss += __shfl_xor(ss, 2); ss += __shfl_xor(ss, 4);
            const float rs = __builtin_amdgcn_rsqf(ss * (1.0f / 128.0f) + EPS);
            u32x4 o0, o1;
#define PP(i) pk2(v[i] * rs * gkn[i], v[i + 1] * rs * gkn[i + 1])
            o0.x = PP(0); o0.y = PP(2); o0.z = PP(4); o0.w = PP(6); o1.x = PP(8); o1.y = PP(10); o1.z = PP(12); o1.w = PP(14);
#undef PP
            *(u32x4*)p = o0; *(u32x4*)(p + 8) = o1;
        }
    }
}

template <int DK, int K1W, int DV, int DVH, bool BIAS>
__device__ __forceinline__ void attn_simple(const bf16_t* Q, int qp, const bf16_t* K1, int k1p, const bf16_t* K2, int k2p, const bf16_t* V, int vp, bf16_t* O, int op,
                                            const float* F2, int nheads, int qhs, int khs, int vhs, int ohs, int gw, int ngw, int lane) {
    const int nitems = BATCH * nheads * (SEQ / 64);
    for (int it = gw; it < nitems; it += ngw) {
        const int g = (SEQ / 64 - 1) - (it % (SEQ / 64)), bh = it / (SEQ / 64), b = bh / nheads, h = bh % nheads;
        const size_t rb = (size_t)b * SEQ; const int q = 64 * g + lane;
        const bf16_t* qrow = Q + (rb + q) * qp + h * qhs;
        const bf16_t* k1 = K1 + rb * k1p + h * khs; const bf16_t* k2 = K2 ? K2 + rb * k2p : nullptr; const bf16_t* vv = V + rb * vp + h * vhs;
        const float* f2 = BIAS ? F2 + ((size_t)b * nheads + h) * SEQ : nullptr;
        for (int vh = 0; vh < DV; vh += DVH) {
        float acc[DVH];
#pragma unroll
        for (int c = 0; c < DVH; ++c) acc[c] = 0.f;
        float m = -1e30f, l = 0.f;
        const int jmax = 64 * g + 63;
        for (int j = 0; j <= jmax; ++j) {
            float s = 0.f;
            const bf16_t* kr1 = k1 + (size_t)j * k1p;
            const bf16_t* qv = qrow; asm volatile("" : "+v"(qv));
#pragma unroll 4
            for (int d = 0; d < K1W; d += 8) { const u32x4 kk = *(const u32x4*)(kr1 + d), qq = *(const u32x4*)(qv + d);
                s += bf2f(kk.x & 0xffffu) * bf2f(qq.x & 0xffffu) + bf2f(kk.x >> 16) * bf2f(qq.x >> 16) + bf2f(kk.y & 0xffffu) * bf2f(qq.y & 0xffffu) + bf2f(kk.y >> 16) * bf2f(qq.y >> 16)
                   + bf2f(kk.z & 0xffffu) * bf2f(qq.z & 0xffffu) + bf2f(kk.z >> 16) * bf2f(qq.z >> 16) + bf2f(kk.w & 0xffffu) * bf2f(qq.w & 0xffffu) + bf2f(kk.w >> 16) * bf2f(qq.w >> 16); }
            if (DK > K1W) { const bf16_t* kr2 = k2 + (size_t)j * k2p;
#pragma unroll 4
                for (int d = 0; d < DK - K1W; d += 8) { const u32x4 kk = *(const u32x4*)(kr2 + d), qq = *(const u32x4*)(qv + K1W + d);
                    s += bf2f(kk.x & 0xffffu) * bf2f(qq.x & 0xffffu) + bf2f(kk.x >> 16) * bf2f(qq.x >> 16) + bf2f(kk.y & 0xffffu) * bf2f(qq.y & 0xffffu) + bf2f(kk.y >> 16) * bf2f(qq.y >> 16)
                       + bf2f(kk.z & 0xffffu) * bf2f(qq.z & 0xffffu) + bf2f(kk.z >> 16) * bf2f(qq.z >> 16) + bf2f(kk.w & 0xffffu) * bf2f(qq.w & 0xffffu) + bf2f(kk.w >> 16) * bf2f(qq.w >> 16); } }
            if (BIAS) s -= f2[j];
            const bool ok = (j <= q);
            const float mn = ok ? fmaxf(m, s) : m;
            const float alpha = exp2f(m - mn); const float pr = ok ? exp2f(s - mn) : 0.f;
            m = mn; l = l * alpha + pr;
            const bf16_t* vr = vv + (size_t)j * vp + vh;
#pragma unroll
            for (int c = 0; c < DVH; c += 8) { const u32x4 w = *(const u32x4*)(vr + c);
                acc[c + 0] = acc[c + 0] * alpha + pr * bf2f(w.x & 0xffffu); acc[c + 1] = acc[c + 1] * alpha + pr * bf2f(w.x >> 16);
                acc[c + 2] = acc[c + 2] * alpha + pr * bf2f(w.y & 0xffffu); acc[c + 3] = acc[c + 3] * alpha + pr * bf2f(w.y >> 16);
                acc[c + 4] = acc[c + 4] * alpha + pr * bf2f(w.z & 0xffffu); acc[c + 5] = acc[c + 5] * alpha + pr * bf2f(w.z >> 16);
                acc[c + 6] = acc[c + 6] * alpha + pr * bf2f(w.w & 0xffffu); acc[c + 7] = acc[c + 7] * alpha + pr * bf2f(w.w >> 16); }
        }
        const float il = 1.0f / l; bf16_t* orow = O + (rb + q) * op + h * ohs + vh;
#pragma unroll
        for (int c = 0; c < DVH; c += 8) { u32x4 w; w.x = pk2(acc[c] * il, acc[c + 1] * il); w.y = pk2(acc[c + 2] * il, acc[c + 3] * il); w.z = pk2(acc[c + 4] * il, acc[c + 5] * il); w.w = pk2(acc[c + 6] * il, acc[c + 7] * il);
            *(u32x4*)(orow + c) = w; }
        }
    }
}


typedef float f32x16 __attribute__((ext_vector_type(16)));
typedef short s16x4 __attribute__((ext_vector_type(4)));
__device__ __forceinline__ s16x4 vtr(const LAS char* p) { return __builtin_bit_cast(s16x4, __builtin_amdgcn_ds_read_tr16_b64_v4i16((LAS s16x4*)p)); }
__device__ __forceinline__ f32x16 mfma32(bf16x8 a, bf16x8 b, f32x16 c) { return __builtin_amdgcn_mfma_f32_32x32x16_bf16(a, b, c, 0, 0, 0); }
__device__ __forceinline__ unsigned cvtpk(float lo, float hi) { unsigned r; asm("v_cvt_pk_bf16_f32 %0, %1, %2" : "=v"(r) : "v"(lo), "v"(hi)); return r; }
__device__ __forceinline__ int crow(int r, int hi) { return (r & 3) + 8 * (r >> 2) + 4 * hi; }

template <bool MLA> struct AttnCfg {
    static constexpr int DK = MLA ? 192 : 64, DV = MLA ? 128 : 64;
    static constexpr int QBW = MLA ? 1 : 2, UR = 256 * QBW;
    static constexpr int KT = MLA ? 64 : 128, NSUB = KT / 64, NSTG = 3;
    static constexpr int KS = DK * 2, VS = DV * 2;
    static constexpr int KBUF = KT * KS, VBUF = KT * VS, BBUF = MLA ? 0 : 1024, STAGE = KBUF + VBUF + BBUF;
    static constexpr int KCH = DK / 8, VCH = DV / 8;
    static constexpr int NKC = KT * KCH / NTHREADS, NVC = KT * VCH / NTHREADS;
    static constexpr int G = NKC + NVC + (MLA ? 0 : 1);
};
struct AttnPtrs { const bf16_t* Q; int qp; const bf16_t* K1; int k1p; const bf16_t* K2; int k2p; const bf16_t* V; int vp; unsigned char* O; int op; const float* F2; };
template <bool MLA, int VAR>
__device__ __forceinline__ void attn_unit(const AttnPtrs& P, int qb, char* lds_, const float MB) {
    typedef AttnCfg<MLA> C;
    const LAS char* lds = (const LAS char*)lds_;
    int tid = threadIdx.x; asm volatile("" : "+v"(tid));
    const int lane = tid & 63, wid = __builtin_amdgcn_readfirstlane(tid >> 6), r32 = lane & 31, hi = lane >> 5;
    const int q0 = qb * C::UR, qw0 = q0 + 32 * C::QBW * wid, NT = (q0 + C::UR) / C::KT;
    bf16x8 qf[C::QBW][C::DK / 16]; float cq[C::QBW];
#pragma unroll
    for (int qi = 0; qi < C::QBW; ++qi) { const bf16_t* qr = P.Q + (size_t)(qw0 + 32 * qi + r32) * P.qp + 8 * hi;
#pragma unroll
      for (int d0 = 0; d0 < C::DK / 16; ++d0) qf[qi][d0] = *(const bf16x8*)(qr + 16 * d0);
      cq[qi] = -MB; if (!MLA) cq[qi] += P.F2[qw0 + 32 * qi + r32]; }
#pragma unroll
    for (int qi = 0; qi < C::QBW; ++qi) {
#pragma unroll
        for (int d0 = 0; d0 < C::DK / 16; ++d0) asm volatile("" : "+v"(qf[qi][d0]));
        asm volatile("" : "+v"(cq[qi])); }
    int t0 = 0;
    if (!MLA) { const float fk = (lane < NT) ? P.F2[C::KT * lane + C::KT - 1] : 0.f; const float fq0 = P.F2[q0];
        const unsigned long long m = __ballot((lane < NT) && (fq0 - fk >= -160.0f)); t0 = __builtin_amdgcn_readfirstlane(m ? (int)__builtin_ctzll(m) : 0); }
    int koff[C::NKC], kstep[C::NKC], voff[C::NVC];
#pragma unroll
    for (int i = 0; i < C::NKC; ++i) { const int u = (wid + 8 * i) * 64 + lane, row = u / C::KCH, cp = u % C::KCH, c = cp ^ ((row >> 1) & 7);
        if (MLA && c >= 16) { koff[i] = (int)((const char*)P.K2 - (const char*)P.K1) + (row * P.k2p + (c - 16) * 8) * 2; kstep[i] = C::KT * P.k2p * 2; } else { koff[i] = (row * P.k1p + c * 8) * 2; kstep[i] = C::KT * P.k1p * 2; } }
#pragma unroll
    for (int i = 0; i < C::NVC; ++i) { const int u = (wid + 8 * i) * 64 + lane, row = u / C::VCH, cp = u % C::VCH, c = MLA ? (cp ^ ((row & 3) << 2)) : (cp ^ (((row >> 1) & 1) << 2));
        voff[i] = (row * P.vp + c * 8) * 2; }
    int vstep = C::KT * P.vp * 2;
    if (VAR == 8) {
#pragma unroll
        for (int i = 0; i < C::NKC; ++i) { koff[i] = ((wid + 8 * i) * 64 + lane) * 16; kstep[i] = C::STAGE; }
#pragma unroll
        for (int i = 0; i < C::NVC; ++i) voff[i] = C::KBUF + ((wid + 8 * i) * 64 + lane) * 16;
        vstep = C::STAGE; }
    int boff = lane * 16 + t0 * C::KT * 4;
    if (!MLA) {
#pragma unroll
        for (int i = 0; i < C::NKC; ++i) koff[i] += t0 * kstep[i];
#pragma unroll
        for (int i = 0; i < C::NVC; ++i) voff[i] += t0 * vstep; }
#define ATT_DMA(stg) do { \
        _Pragma("unroll") for (int i = 0; i < C::NKC; ++i) { __builtin_amdgcn_global_load_lds((const unsigned*)((const char*)P.K1 + koff[i]), (LAS unsigned*)(lds_ + (stg) * C::STAGE + (wid + 8 * i) * 1024), 16, 0, 0); koff[i] += kstep[i]; } \
        _Pragma("unroll") for (int i = 0; i < C::NVC; ++i) { __builtin_amdgcn_global_load_lds((const unsigned*)((const char*)P.V + voff[i]), (LAS unsigned*)(lds_ + (stg) * C::STAGE + C::KBUF + (wid + 8 * i) * 1024), 16, 0, 0); voff[i] += vstep; } \
        if (!MLA) { __builtin_amdgcn_global_load_lds((const unsigned*)((const char*)P.F2 + boff), (LAS unsigned*)(lds_ + (stg) * C::STAGE + C::KBUF + C::VBUF), 16, 0, 0); boff += C::KT * 4; } } while (0)
    ATT_DMA(0); ATT_DMA(1);
    f32x16 oT[C::QBW][C::DV / 32];
#pragma unroll
    for (int qi = 0; qi < C::QBW; ++qi)
#pragma unroll
        for (int d0 = 0; d0 < C::DV / 32; ++d0)
#pragma unroll
            for (int r = 0; r < 16; ++r) oT[qi][d0][r] = 0.f;
    float l_run[C::QBW];
#pragma unroll
    for (int qi = 0; qi < C::QBW; ++qi) l_run[qi] = 0.f;
    int kb4[4];
#pragma unroll
    for (int j = 0; j < 4; ++j) kb4[j] = r32 * C::KS + (((2 * j + hi) ^ ((r32 >> 1) & 7)) * 16);
    const int vq = (lane & 15) >> 2;
    int vb4[C::DV / 32];
#pragma unroll
    for (int d0 = 0; d0 < C::DV / 32; ++d0) vb4[d0] = C::KBUF + (4 * hi + vq) * C::VS + ((MLA ? (d0 ^ vq) : (d0 ^ (vq >> 1))) * 64) + ((lane >> 4) & 1) * 32 + (lane & 3) * 8;
    int stg = 0;
    for (int t = t0; t < NT; ++t) {
        if (t + 1 < NT) asm volatile("s_waitcnt vmcnt(%0)" :: "n"(C::G) : "memory"); else asm volatile("s_waitcnt vmcnt(0)" ::: "memory");
        asm volatile("s_waitcnt lgkmcnt(0)" ::: "memory");
        if (VAR != 3) __builtin_amdgcn_s_barrier();
        if (VAR == 0 || VAR == 2 || VAR == 7 || VAR == 8) if (t + 2 < NT) { const int s2 = stg >= 1 ? stg - 1 : 2; ATT_DMA(s2); }
        const LAS char* sbase = lds + stg * C::STAGE;
#pragma unroll
        for (int sub = 0; sub < C::NSUB; ++sub) {
            const int kb = t * C::KT + 64 * sub;
            if (kb > qw0 + 32 * C::QBW - 1) continue;
            if (VAR == 2) continue;
            const LAS char* sk = sbase + sub * 64 * C::KS; const LAS char* sv = sbase + sub * 64 * C::VS;
            f32x16 p[C::QBW][2];
            if (MLA) {
#pragma unroll
                for (int qi = 0; qi < C::QBW; ++qi)
#pragma unroll
                    for (int r = 0; r < 16; ++r) { p[qi][0][r] = cq[qi]; p[qi][1][r] = cq[qi]; }
            } else {
#pragma unroll
                for (int g = 0; g < 4; ++g) { const f32x4 b0 = *(const LAS f32x4*)(sbase + C::KBUF + C::VBUF + (64 * sub + 8 * g + 4 * hi) * 4), b1 = *(const LAS f32x4*)(sbase + C::KBUF + C::VBUF + (64 * sub + 32 + 8 * g + 4 * hi) * 4);
#pragma unroll
                    for (int qi = 0; qi < C::QBW; ++qi)
#pragma unroll
                        for (int j = 0; j < 4; ++j) { p[qi][0][4 * g + j] = cq[qi] - b0[j]; p[qi][1][4 * g + j] = cq[qi] - b1[j]; } }
            }
            if (VAR != 5) {
                constexpr int ND = C::DK / 16, PFK = MLA ? 3 : 1;
                bf16x8 kf[PFK + 1][2];
                unsigned kaddr[4];
#pragma unroll
                for (int j = 0; j < 4; ++j) kaddr[j] = (unsigned)(uintptr_t)(sk + (VAR == 6 ? 0 : kb4[j]));
#define KRD2(slot, d) do { asm volatile("ds_read_b128 %0, %1 offset:%2" : "=v"(kf[slot][0]) : "v"(kaddr[(d) & 3]), "n"(((d) >> 2) * 128)); \
                           asm volatile("ds_read_b128 %0, %1 offset:%2" : "=v"(kf[slot][1]) : "v"(kaddr[(d) & 3]), "n"(((d) >> 2) * 128 + 32 * C::KS)); } while (0)
                asm volatile("s_waitcnt lgkmcnt(0)" ::: "memory");
#pragma unroll
                for (int d0 = 0; d0 < PFK; ++d0) KRD2(d0, d0);
#pragma unroll
                for (int d0 = 0; d0 < ND; ++d0) {
                    if (d0 + PFK < ND) { KRD2((d0 + PFK) % (PFK + 1), d0 + PFK); asm volatile("s_waitcnt lgkmcnt(%0)" :: "n"(2 * PFK) : "memory"); }
                    else asm volatile("s_waitcnt lgkmcnt(%0)" :: "n"(2 * (ND - 1 - d0)) : "memory");
                    __builtin_amdgcn_sched_barrier(0);
#pragma unroll
                    for (int qi = 0; qi < C::QBW; ++qi) { p[qi][0] = mfma32(kf[d0 % (PFK + 1)][0], qf[qi][d0], p[qi][0]); p[qi][1] = mfma32(kf[d0 % (PFK + 1)][1], qf[qi][d0], p[qi][1]); }
                    __builtin_amdgcn_sched_barrier(0);
                }
#undef KRD2
            }
            bf16x8 pb[C::QBW][4];
#pragma unroll
            for (int qi = 0; qi < C::QBW; ++qi) {
                const int qwi = qw0 + 32 * qi;
                if (kb + 63 > qwi) {
                    const int dq = qwi + r32 - kb - 4 * hi;
#pragma unroll
                    for (int r = 0; r < 16; ++r) { const int c = (r & 3) + 8 * (r >> 2); if (c > dq) p[qi][0][r] = -__builtin_inff(); if (c + 32 > dq) p[qi][1][r] = -__builtin_inff(); }
                }
                float ps = 0.f;
#pragma unroll
                for (int r = 0; r < 16; ++r) { p[qi][0][r] = __builtin_amdgcn_exp2f(p[qi][0][r]); p[qi][1][r] = __builtin_amdgcn_exp2f(p[qi][1][r]); ps += p[qi][0][r] + p[qi][1][r]; }
                l_run[qi] += ps;
#pragma unroll
                for (int s = 0; s < 4; ++s) { u32x4 w; const f32x16& pp = p[qi][s >> 1]; const int o = 8 * (s & 1);
                    w.x = cvtpk(pp[o + 0], pp[o + 1]); w.y = cvtpk(pp[o + 2], pp[o + 3]); w.z = cvtpk(pp[o + 4], pp[o + 5]); w.w = cvtpk(pp[o + 6], pp[o + 7]);
                    pb[qi][s] = __builtin_bit_cast(bf16x8, w); }
            }
            if (VAR != 4) {
                constexpr int NM = (C::DV / 32) * 4, PFV = MLA ? 3 : 2;
                s16x4 vl[PFV + 1], vh[PFV + 1];
#define VTR2(slot, n) do { asm volatile("ds_read_b64_tr_b16 %0, %1 offset:%2" : "=v"(vl[slot]) : "v"(vaddr[(n) >> 2]), "n"(((n) & 3) * 16 * C::VS)); \
                           asm volatile("ds_read_b64_tr_b16 %0, %1 offset:%2" : "=v"(vh[slot]) : "v"(vaddr[(n) >> 2]), "n"(((n) & 3) * 16 * C::VS + 8 * C::VS)); } while (0)
                unsigned vaddr[C::DV / 32];
#pragma unroll
                for (int d0 = 0; d0 < C::DV / 32; ++d0) vaddr[d0] = (unsigned)(uintptr_t)(sv + (VAR == 6 ? C::KBUF : vb4[d0]));
                asm volatile("s_waitcnt lgkmcnt(0)" ::: "memory");
#pragma unroll
                for (int i = 0; i < PFV; ++i) VTR2(i, i);
#pragma unroll
                for (int i = 0; i < NM; ++i) {
                    if (i + PFV < NM) { VTR2((i + PFV) % (PFV + 1), i + PFV); asm volatile("s_waitcnt lgkmcnt(%0)" :: "n"(2 * PFV) : "memory"); }
                    else asm volatile("s_waitcnt lgkmcnt(%0)" :: "n"(2 * (NM - 1 - i)) : "memory");
                    __builtin_amdgcn_sched_barrier(0);
                    const s16x4 lo = vl[i % (PFV + 1)], hh = vh[i % (PFV + 1)];
                    const bf16x8 vf = (bf16x8){lo[0], lo[1], lo[2], lo[3], hh[0], hh[1], hh[2], hh[3]};
#pragma unroll
                    for (int qi = 0; qi < C::QBW; ++qi) oT[qi][i >> 2] = mfma32(vf, pb[qi][i & 3], oT[qi][i >> 2]);
                    __builtin_amdgcn_sched_barrier(0);
                }
#undef VTR2
            }
        }
        stg = stg == 2 ? 0 : stg + 1;
    }
    asm volatile("s_waitcnt lgkmcnt(0)" ::: "memory");
    __builtin_amdgcn_s_barrier();
#pragma unroll
    for (int qi = 0; qi < C::QBW; ++qi) {
        float l = l_run[qi]; l += __shfl_xor(l, 32);
        const float il = (F8_P4 ? F8_SX : 1.0f) / l; unsigned char* orow = P.O + (size_t)(qw0 + 32 * qi + r32) * P.op + (F8_P4 ? 4 : 8) * hi;
#pragma unroll
        for (int d0 = 0; d0 < C::DV / 32; ++d0)
#pragma unroll
            for (int g = 0; g < 4; ++g) { const f32x4 ov = (f32x4){oT[qi][d0][4 * g] * il, oT[qi][d0][4 * g + 1] * il, oT[qi][d0][4 * g + 2] * il, oT[qi][d0][4 * g + 3] * il};
                if (F8_P4) *(unsigned*)(orow + 32 * d0 + 8 * g) = pk4_fp8(ov); else *(u32x2*)(orow + 64 * d0 + 16 * g) = pk4(ov); }
    }
#undef ATT_DMA
}
typedef int v4i_t __attribute__((ext_vector_type(4)));
template <bool MLA> struct AttnCfg8 {
    static constexpr int DK = MLA ? 192 : 64, DV = MLA ? 128 : 64, NDC = DK / 64;
    static constexpr int QBW = MLA ? 1 : 2, UR = 256 * QBW;
    static constexpr int KT = MLA ? (MLA_KT128 ? 128 : 64) : (FOX_KT256 ? 256 : 128), NSUB = KT / 64, NSTG = ((MLA && MLA_KT128) || (!MLA && FOX_KT256)) ? 2 : 3;
    static constexpr int KS = DK, VS = DV * 2;
    static constexpr int KBUF = KT * KS, VBUF = KT * VS, BBUF = MLA ? 0 : (FOX_BIAS_MFMA ? KT * 16 : 1024), NBP = BBUF / 1024, STAGE = KBUF + VBUF + BBUF;
    static constexpr int KCH = KS / 16, VCH = DV / 8;
    static constexpr int NKP = KBUF / 1024, NKW = (NKP + 7) / 8;
    static constexpr int NVC = KT * VCH / NTHREADS;
};
struct AttnPtrs8 { const unsigned char* Q; int qp; const unsigned char* K1; int k1p; const unsigned char* K2; int k2p; const bf16_t* V; int vp; unsigned char* O; int op; const float* F2; const unsigned char* FR; };
template <bool MLA>
__device__ __forceinline__ void attn_unit8(const AttnPtrs8& P, int qb, char* lds_, const float MB) {
    typedef AttnCfg8<MLA> C;
    const LAS char* lds = (const LAS char*)lds_;
    int tid = threadIdx.x; asm volatile("" : "+v"(tid));
    const int lane = tid & 63, wid = __builtin_amdgcn_readfirstlane(tid >> 6), r32 = lane & 31, hi = lane >> 5;
    const int q0 = qb * C::UR, qw0 = q0 + 32 * C::QBW * wid, NT = (q0 + C::UR) / C::KT;
    v8i qf[C::QBW][C::NDC]; float cq[C::QBW];
#pragma unroll
    for (int qi = 0; qi < C::QBW; ++qi) { const unsigned char* qr = P.Q + (size_t)(qw0 + 32 * qi + r32) * P.qp + 32 * hi;
#pragma unroll
      for (int m = 0; m < C::NDC; ++m) { const v4i_t a = *(const v4i_t*)(qr + 64 * m), b = *(const v4i_t*)(qr + 64 * m + 16); qf[qi][m] = __builtin_shufflevector(a, b, 0, 1, 2, 3, 4, 5, 6, 7); }
      cq[qi] = -MB; if (!MLA) cq[qi] += P.F2[qw0 + 32 * qi + r32]; }
    bf16x8 bq[C::QBW];
    if (!MLA && FOX_BIAS_MFMA) {
#pragma unroll
        for (int qi = 0; qi < C::QBW; ++qi) { const float x = cq[qi]; const unsigned c1 = f2bf(x); const float r1 = x - bf2f(c1); const unsigned c2 = f2bf(r1); const unsigned c3 = f2bf(r1 - bf2f(c2));
            u32x4 w = (u32x4){c1 | (c2 << 16), c3 | 0xbf800000u, 0xbf80bf80u, 0u}; if (hi) w = (u32x4){0u, 0u, 0u, 0u};
            bq[qi] = __builtin_bit_cast(bf16x8, w); asm volatile("" : "+v"(bq[qi])); } }
#pragma unroll
    for (int qi = 0; qi < C::QBW; ++qi) {
#pragma unroll
        for (int m = 0; m < C::NDC; ++m) asm volatile("" : "+v"(qf[qi][m]));
        asm volatile("" : "+v"(cq[qi])); }
    int t0 = 0;
    int s0w = 0;
    if (!MLA) {
        const float TS = 2.0f * MB + 40.0f;
        const float fk = (lane < NT) ? P.F2[C::KT * lane + C::KT - 1] : 0.f; const float fq0 = P.F2[q0];
        const unsigned long long m = __ballot((lane < NT) && (fq0 - fk >= -TS)); t0 = __builtin_amdgcn_readfirstlane(m ? (int)__builtin_ctzll(m) : 0);
        const int ns = qw0 / 64 + 1; const float fqw = P.F2[qw0];
        const float f0 = (lane < ns) ? P.F2[64 * lane + 63] : 0.f, f1 = (lane + 64 < ns) ? P.F2[64 * (lane + 64) + 63] : 0.f;
        const unsigned long long m0 = __ballot((lane < ns) && (fqw - f0 >= -TS)), m1 = __ballot((lane + 64 < ns) && (fqw - f1 >= -TS));
        s0w = __builtin_amdgcn_readfirstlane(m0 ? (int)__builtin_ctzll(m0) : (m1 ? 64 + (int)__builtin_ctzll(m1) : ns - 1)); }
    const bool two_k = MLA && !MLA_KT128 && wid < 4;
    constexpr int NKW = (MLA && !MLA_KT128) ? 2 : C::NKW;
    int koff[NKW], kstep[NKW], voff[C::NVC];
#pragma unroll
    for (int i = 0; i < NKW; ++i) { const int u = (wid + 8 * i) * 64 + lane, row = u / C::KCH, cp = u % C::KCH, c = cp ^ ((row >> 2) & 3);
        if (MLA && c >= 8) { koff[i] = (int)(P.K2 - P.K1) + row * P.k2p + (c - 8) * 16; kstep[i] = C::KT * P.k2p; } else { koff[i] = row * P.k1p + c * 16; kstep[i] = C::KT * P.k1p; } }
#pragma unroll
    for (int i = 0; i < C::NVC; ++i) { const int u = (wid + 8 * i) * 64 + lane, row = u / C::VCH, cp = u % C::VCH, c = MLA ? (cp ^ ((row & 3) << 2)) : (cp ^ (((row >> 1) & 1) << 2));
        voff[i] = (row * P.vp + c * 8) * 2; }
    const int vstep = C::KT * P.vp * 2;
    const int bpc = (!MLA && FOX_BIAS_MFMA) ? (wid & (C::NBP - 1)) * 1024 : 0;
    int boff = (!MLA && FOX_BIAS_MFMA) ? lane * 16 + bpc + t0 * C::KT * 16 : lane * 16 + t0 * C::KT * 4;
    if (!MLA) {
#pragma unroll
        for (int i = 0; i < NKW; ++i) koff[i] += t0 * kstep[i];
#pragma unroll
        for (int i = 0; i < C::NVC; ++i) voff[i] += t0 * vstep; }
#define ATT_DMA(stg) do { \
        __builtin_amdgcn_global_load_lds((const unsigned*)(P.K1 + koff[0]), (LAS unsigned*)(lds_ + (stg) * C::STAGE + wid * 1024), 16, 0, 0); koff[0] += kstep[0]; \
        if (C::NSTG == 2) { _Pragma("unroll") for (int i = 1; i < NKW; ++i) { __builtin_amdgcn_global_load_lds((const unsigned*)(P.K1 + koff[i]), (LAS unsigned*)(lds_ + (stg) * C::STAGE + (wid + 8 * i) * 1024), 16, 0, 0); koff[i] += kstep[i]; } } \
        else if (two_k) { __builtin_amdgcn_global_load_lds((const unsigned*)(P.K1 + koff[1]), (LAS unsigned*)(lds_ + (stg) * C::STAGE + (wid + 8) * 1024), 16, 0, 0); koff[1] += kstep[1]; } \
        _Pragma("unroll") for (int i = 0; i < C::NVC; ++i) { __builtin_amdgcn_global_load_lds((const unsigned*)((const char*)P.V + voff[i]), (LAS unsigned*)(lds_ + (stg) * C::STAGE + C::KBUF + (wid + 8 * i) * 1024), 16, 0, 0); voff[i] += vstep; } \
        if (!MLA) { if (FOX_BIAS_MFMA) { __builtin_amdgcn_global_load_lds((const unsigned*)(P.FR + boff), (LAS unsigned*)(lds_ + (stg) * C::STAGE + C::KBUF + C::VBUF + bpc), 16, 0, 0); boff += C::KT * 16; } \
                    else { __builtin_amdgcn_global_load_lds((const unsigned*)((const char*)P.F2 + boff), (LAS unsigned*)(lds_ + (stg) * C::STAGE + C::KBUF + C::VBUF), 16, 0, 0); boff += C::KT * 4; } } } while (0)
    ATT_DMA(0); if (C::NSTG == 3) ATT_DMA(1);
    f32x16 oT[C::QBW][C::DV / 32];
#pragma unroll
    for (int qi = 0; qi < C::QBW; ++qi)
#pragma unroll
        for (int d0 = 0; d0 < C::DV / 32; ++d0)
#pragma unroll
            for (int r = 0; r < 16; ++r) oT[qi][d0][r] = 0.f;
    float l_run[C::QBW];
#pragma unroll
    for (int qi = 0; qi < C::QBW; ++qi) l_run[qi] = 0.f;
    int kb2[2];
#pragma unroll
    for (int j = 0; j < 2; ++j) kb2[j] = r32 * C::KS + (((2 * hi + j) ^ ((r32 >> 2) & 3)) * 16);
    const int vq = (lane & 15) >> 2;
    int vb4[C::DV / 32];
#pragma unroll
    for (int d0 = 0; d0 < C::DV / 32; ++d0) vb4[d0] = C::KBUF + (4 * hi + vq) * C::VS + ((MLA ? (d0 ^ vq) : (d0 ^ (vq >> 1))) * 64) + ((lane >> 4) & 1) * 32 + (lane & 3) * 8;
    const int sclK = 0x7b7b7b7b, sclQ = 0x79797979;
    int stg = 0;
    for (int t = t0; t < NT; ++t) {
        if (C::NSTG == 2) asm volatile("s_waitcnt vmcnt(0)" ::: "memory");
        else if (t + 1 < NT) { if (MLA) { if (two_k) asm volatile("s_waitcnt vmcnt(4)" ::: "memory"); else asm volatile("s_waitcnt vmcnt(3)" ::: "memory"); } else asm volatile("s_waitcnt vmcnt(4)" ::: "memory"); }
        else asm volatile("s_waitcnt vmcnt(0)" ::: "memory");
        asm volatile("s_waitcnt lgkmcnt(0)" ::: "memory");
        __builtin_amdgcn_s_barrier();
        if (C::NSTG == 2) { if (t + 1 < NT) { const int s1 = stg ^ 1; ATT_DMA(s1); } }
        else if (t + 2 < NT) { const int s2 = stg >= 1 ? stg - 1 : 2; ATT_DMA(s2); }
        const LAS char* sbase = lds + stg * C::STAGE;
#pragma unroll
        for (int sub = 0; sub < C::NSUB; ++sub) {
            const int kb = t * C::KT + 64 * sub;
            if (kb > qw0 + 32 * C::QBW - 1) continue;
            if (!MLA && t * C::NSUB + sub < s0w) continue;
            const LAS char* sk = sbase + sub * 64 * C::KS; const LAS char* sv = sbase + sub * 64 * C::VS;
            f32x16 p[C::QBW][2];
            if (MLA) {
#pragma unroll
                for (int qi = 0; qi < C::QBW; ++qi)
#pragma unroll
                    for (int r = 0; r < 16; ++r) { p[qi][0][r] = cq[qi]; p[qi][1][r] = cq[qi]; }
            } else if (FOX_BIAS_MFMA) {
                f32x16 z16;
#pragma unroll
                for (int r = 0; r < 16; ++r) z16[r] = 0.f;
#pragma unroll
                for (int kh = 0; kh < 2; ++kh) { const bf16x8 ar = *(const LAS bf16x8*)(sbase + C::KBUF + C::VBUF + (64 * sub + 32 * kh + r32) * 16);
#pragma unroll
                    for (int qi = 0; qi < C::QBW; ++qi) p[qi][kh] = mfma32(ar, bq[qi], z16); }
            } else {
#pragma unroll
                for (int g = 0; g < 4; ++g) { const f32x4 b0 = *(const LAS f32x4*)(sbase + C::KBUF + C::VBUF + (64 * sub + 8 * g + 4 * hi) * 4), b1 = *(const LAS f32x4*)(sbase + C::KBUF + C::VBUF + (64 * sub + 32 + 8 * g + 4 * hi) * 4);
#pragma unroll
                    for (int qi = 0; qi < C::QBW; ++qi)
#pragma unroll
                        for (int j = 0; j < 4; ++j) { p[qi][0][4 * g + j] = cq[qi] - b0[j]; p[qi][1][4 * g + j] = cq[qi] - b1[j]; } }
            }
            {
                v8i kop[C::NDC][2];
#pragma unroll
                for (int m = 0; m < C::NDC; ++m)
#pragma unroll
                    for (int kh = 0; kh < 2; ++kh) { const LAS char* kp = sk + kh * 32 * C::KS + m * 64;
                        const v4i_t a = *(const LAS v4i_t*)(kp + kb2[0]), b = *(const LAS v4i_t*)(kp + kb2[1]); kop[m][kh] = __builtin_shufflevector(a, b, 0, 1, 2, 3, 4, 5, 6, 7); }
#pragma unroll
                for (int qi = 0; qi < C::QBW; ++qi) asm volatile("s_nop 7" : "+v"(p[qi][0]), "+v"(p[qi][1]));
#pragma unroll
                for (int m = 0; m < C::NDC; ++m)
#pragma unroll
                    for (int kh = 0; kh < 2; ++kh)
#pragma unroll
                        for (int qi = 0; qi < C::QBW; ++qi)
                            asm volatile("v_mfma_scale_f32_32x32x64_f8f6f4 %0, %1, %2, %0, %3, %4 op_sel_hi:[0,0,0]" : "+v"(p[qi][kh]) : "v"(kop[m][kh]), "v"(qf[qi][m]), "v"(sclK), "v"(sclQ));
#pragma unroll
                for (int qi = 0; qi < C::QBW; ++qi) asm volatile("s_nop 15\n\ts_nop 7" : "+v"(p[qi][0]), "+v"(p[qi][1]));
            }
            bf16x8 pb[C::QBW][4];
#pragma unroll
            for (int qi = 0; qi < C::QBW; ++qi) {
                const int qwi = qw0 + 32 * qi;
                if (kb + 63 > qwi) {
                    const int dq = qwi + r32 - kb - 4 * hi;
#pragma unroll
                    for (int r = 0; r < 16; ++r) { const int c = (r & 3) + 8 * (r >> 2); if (c > dq) p[qi][0][r] = -__builtin_inff(); if (c + 32 > dq) p[qi][1][r] = -__builtin_inff(); }
                }
                float ps = 0.f;
#pragma unroll
                for (int r = 0; r < 16; ++r) { p[qi][0][r] = __builtin_amdgcn_exp2f(p[qi][0][r]); p[qi][1][r] = __builtin_amdgcn_exp2f(p[qi][1][r]); ps += p[qi][0][r] + p[qi][1][r]; }
                l_run[qi] += ps;
#pragma unroll
                for (int s = 0; s < 4; ++s) { u32x4 w; const f32x16& pp = p[qi][s >> 1]; const int o = 8 * (s & 1);
                    w.x = cvtpk(pp[o + 0], pp[o + 1]); w.y = cvtpk(pp[o + 2], pp[o + 3]); w.z = cvtpk(pp[o + 4], pp[o + 5]); w.w = cvtpk(pp[o + 6], pp[o + 7]);
                    pb[qi][s] = __builtin_bit_cast(bf16x8, w); }
            }
            {
                constexpr int NM = (C::DV / 32) * 4, PFV = MLA ? 3 : 2;
                s16x4 vl[PFV + 1], vh[PFV + 1];
#define VTR2(slot, n) do { asm volatile("ds_read_b64_tr_b16 %0, %1 offset:%2" : "=v"(vl[slot]) : "v"(vaddr[(n) >> 2]), "n"(((n) & 3) * 16 * C::VS)); \
                           asm volatile("ds_read_b64_tr_b16 %0, %1 offset:%2" : "=v"(vh[slot]) : "v"(vaddr[(n) >> 2]), "n"(((n) & 3) * 16 * C::VS + 8 * C::VS)); } while (0)
                unsigned vaddr[C::DV / 32];
#pragma unroll
                for (int d0 = 0; d0 < C::DV / 32; ++d0) vaddr[d0] = (unsigned)(uintptr_t)(sv + vb4[d0]);
                asm volatile("s_waitcnt lgkmcnt(0)" ::: "memory");
#pragma unroll
                for (int i = 0; i < PFV; ++i) VTR2(i, i);
#pragma unroll
                for (int i = 0; i < NM; ++i) {
                    if (i + PFV < NM) { VTR2((i + PFV) % (PFV + 1), i + PFV); asm volatile("s_waitcnt lgkmcnt(%0)" :: "n"(2 * PFV) : "memory"); }
                    else asm volatile("s_waitcnt lgkmcnt(%0)" :: "n"(2 * (NM - 1 - i)) : "memory");
                    __builtin_amdgcn_sched_barrier(0);
                    const s16x4 lo = vl[i % (PFV + 1)], hh = vh[i % (PFV + 1)];
                    const bf16x8 vf = (bf16x8){lo[0], lo[1], lo[2], lo[3], hh[0], hh[1], hh[2], hh[3]};
#pragma unroll
                    for (int qi = 0; qi < C::QBW; ++qi) oT[qi][i >> 2] = mfma32(vf, pb[qi][i & 3], oT[qi][i >> 2]);
                    __builtin_amdgcn_sched_barrier(0);
                }
#undef VTR2
            }
        }
        stg = (C::NSTG == 2) ? (stg ^ 1) : (stg == 2 ? 0 : stg + 1);
    }
    asm volatile("s_waitcnt lgkmcnt(0)" ::: "memory");
    __builtin_amdgcn_s_barrier();
#pragma unroll
    for (int qi = 0; qi < C::QBW; ++qi) {
        float l = l_run[qi]; l += __shfl_xor(l, 32);
        const float il = (F8_P4 ? F8_SX : 1.0f) / l; unsigned char* orow = P.O + (size_t)(qw0 + 32 * qi + r32) * P.op + (F8_P4 ? 4 : 8) * hi;
#pragma unroll
        for (int d0 = 0; d0 < C::DV / 32; ++d0)
#pragma unroll
            for (int g = 0; g < 4; ++g) { const f32x4 ov = (f32x4){oT[qi][d0][4 * g] * il, oT[qi][d0][4 * g + 1] * il, oT[qi][d0][4 * g + 2] * il, oT[qi][d0][4 * g + 3] * il};
                if (F8_P4) *(unsigned*)(orow + 32 * d0 + 8 * g) = pk4_fp8(ov); else *(u32x2*)(orow + 64 * d0 + 16 * g) = pk4(ov); }
    }
#undef ATT_DMA
}
__device__ __forceinline__ void attn_unit_mla_pipe(const AttnPtrs& P, int qb, char* lds_, const float MB) {
    typedef AttnCfg<true> C;
    const LAS char* lds = (const LAS char*)lds_;
    int tid = threadIdx.x; asm volatile("" : "+v"(tid));
    const int lane = tid & 63, wid = __builtin_amdgcn_readfirstlane(tid >> 6), r32 = lane & 31, hi = lane >> 5;
    const int q0 = qb * 256, qw0 = q0 + 32 * wid, NT = (q0 + 256) / 64;
    bf16x8 qf[12];
    { const bf16_t* qr = P.Q + (size_t)(qw0 + r32) * P.qp + 8 * hi;
#pragma unroll
      for (int d0 = 0; d0 < 12; ++d0) qf[d0] = *(const bf16x8*)(qr + 16 * d0); }
#pragma unroll
    for (int d0 = 0; d0 < 12; ++d0) asm volatile("" : "+v"(qf[d0]));
    const float cq = -MB;
    int koff[C::NKC], kstep[C::NKC], voff[C::NVC];
#pragma unroll
    for (int i = 0; i < C::NKC; ++i) { const int u = (wid + 8 * i) * 64 + lane, row = u / C::KCH, cp = u % C::KCH, c = cp ^ ((row >> 1) & 7);
        if (c >= 16) { koff[i] = (int)((const char*)P.K2 - (const char*)P.K1) + (row * P.k2p + (c - 16) * 8) * 2; kstep[i] = 64 * P.k2p * 2; } else { koff[i] = (row * P.k1p + c * 8) * 2; kstep[i] = 64 * P.k1p * 2; } }
#pragma unroll
    for (int i = 0; i < C::NVC; ++i) { const int u = (wid + 8 * i) * 64 + lane, row = u / C::VCH, cp = u % C::VCH, c = cp ^ ((row & 3) << 2); voff[i] = (row * P.vp + c * 8) * 2; }
    const int vstep = 64 * P.vp * 2;
#define ATT_DMA(stg) do { \
        _Pragma("unroll") for (int i = 0; i < C::NKC; ++i) { __builtin_amdgcn_global_load_lds((const unsigned*)((const char*)P.K1 + koff[i]), (LAS unsigned*)(lds_ + (stg) * C::STAGE + (wid + 8 * i) * 1024), 16, 0, 0); koff[i] += kstep[i]; } \
        _Pragma("unroll") for (int i = 0; i < C::NVC; ++i) { __builtin_amdgcn_global_load_lds((const unsigned*)((const char*)P.V + voff[i]), (LAS unsigned*)(lds_ + (stg) * C::STAGE + C::KBUF + (wid + 8 * i) * 1024), 16, 0, 0); voff[i] += vstep; } } while (0)
    ATT_DMA(0); ATT_DMA(1);
    f32x16 oT[4];
#pragma unroll
    for (int d0 = 0; d0 < 4; ++d0)
#pragma unroll
        for (int r = 0; r < 16; ++r) oT[d0][r] = 0.f;
    float l_run = 0.f;
    int kb4[4];
#pragma unroll
    for (int j = 0; j < 4; ++j) kb4[j] = r32 * C::KS + (((2 * j + hi) ^ ((r32 >> 1) & 7)) * 16);
    const int vq = (lane & 15) >> 2;
    int vb4[4];
#pragma unroll
    for (int d0 = 0; d0 < 4; ++d0) vb4[d0] = C::KBUF + (4 * hi + vq) * C::VS + ((d0 ^ vq) * 64) + ((lane >> 4) & 1) * 32 + (lane & 3) * 8;
    constexpr int PFK = 3, PFV = 3, ND = 12, NM = 16;
    bf16x8 kf[PFK + 1]; unsigned kaddr[4]; s16x4 vl[PFV + 1], vh[PFV + 1]; unsigned vaddr[4]; bf16x8 pb[4];
#define KRD1(slot, d, half) asm volatile("ds_read_b128 %0, %1 offset:%2" : "=v"(kf[slot]) : "v"(kaddr[(d) & 3]), "n"(((d) >> 2) * 128 + (half) * 32 * C::KS))
#define VTR2(slot, n) do { asm volatile("ds_read_b64_tr_b16 %0, %1 offset:%2" : "=v"(vl[slot]) : "v"(vaddr[(n) >> 2]), "n"(((n) & 3) * 16 * C::VS)); \
                           asm volatile("ds_read_b64_tr_b16 %0, %1 offset:%2" : "=v"(vh[slot]) : "v"(vaddr[(n) >> 2]), "n"(((n) & 3) * 16 * C::VS + 8 * C::VS)); } while (0)
#define SMCH(T, c, pbb) do { const int e_ = 2 * (c); T[e_] = __builtin_amdgcn_exp2f(T[e_]); T[e_ + 1] = __builtin_amdgcn_exp2f(T[e_ + 1]); ps += T[e_] + T[e_ + 1]; \
        if (((c) & 3) == 3) { const int s_ = (c) >> 2; u32x4 w_; w_.x = cvtpk(T[8 * s_ + 0], T[8 * s_ + 1]); w_.y = cvtpk(T[8 * s_ + 2], T[8 * s_ + 3]); w_.z = cvtpk(T[8 * s_ + 4], T[8 * s_ + 5]); w_.w = cvtpk(T[8 * s_ + 6], T[8 * s_ + 7]); \
            pb[(pbb) + s_] = __builtin_bit_cast(bf16x8, w_); } } while (0)
#define QK_HALF(S, half, STG, DOSM, T, pbb) do { \
        _Pragma("unroll") for (int r = 0; r < 16; ++r) S[r] = cq; \
        const LAS char* sk_ = lds + (STG) * C::STAGE; \
        _Pragma("unroll") for (int j = 0; j < 4; ++j) kaddr[j] = (unsigned)(uintptr_t)(sk_ + kb4[j]); \
        asm volatile("s_waitcnt lgkmcnt(0)" ::: "memory"); \
        _Pragma("unroll") for (int d0 = 0; d0 < PFK; ++d0) KRD1(d0, d0, half); \
        _Pragma("unroll") for (int d0 = 0; d0 < ND; ++d0) { \
            if (d0 + PFK < ND) { KRD1((d0 + PFK) % (PFK + 1), d0 + PFK, half); asm volatile("s_waitcnt lgkmcnt(%0)" :: "n"(PFK) : "memory"); } \
            else asm volatile("s_waitcnt lgkmcnt(%0)" :: "n"(ND - 1 - d0) : "memory"); \
            __builtin_amdgcn_sched_barrier(0); \
            S = mfma32(kf[d0 % (PFK + 1)], qf[d0], S); \
            __builtin_amdgcn_sched_barrier(0); \
            if (DOSM) { if (d0 < 8) SMCH(T, d0, pbb); __builtin_amdgcn_sched_barrier(0); } \
        } } while (0)
#define MASKH(T, j, half) do { const int kb_ = 64 * (j) + 32 * (half); if (kb_ + 31 > qw0) { const int dq = qw0 + r32 - kb_ - 4 * hi; \
        _Pragma("unroll") for (int r = 0; r < 16; ++r) { const int c = (r & 3) + 8 * (r >> 2); if (c > dq) T[r] = -__builtin_inff(); } } } while (0)
#define PV_TILE(STG) do { const LAS char* sv_ = lds + (STG) * C::STAGE; \
        _Pragma("unroll") for (int d0 = 0; d0 < 4; ++d0) vaddr[d0] = (unsigned)(uintptr_t)(sv_ + vb4[d0]); \
        asm volatile("s_waitcnt lgkmcnt(0)" ::: "memory"); \
        _Pragma("unroll") for (int i = 0; i < PFV; ++i) VTR2(i, i); \
        _Pragma("unroll") for (int i = 0; i < NM; ++i) { \
            if (i + PFV < NM) { VTR2((i + PFV) % (PFV + 1), i + PFV); asm volatile("s_waitcnt lgkmcnt(%0)" :: "n"(2 * PFV) : "memory"); } \
            else asm volatile("s_waitcnt lgkmcnt(%0)" :: "n"(2 * (NM - 1 - i)) : "memory"); \
            __builtin_amdgcn_sched_barrier(0); \
            const s16x4 lo = vl[i % (PFV + 1)], hh = vh[i % (PFV + 1)]; \
            const bf16x8 vf = (bf16x8){lo[0], lo[1], lo[2], lo[3], hh[0], hh[1], hh[2], hh[3]}; \
            oT[i >> 2] = mfma32(vf, pb[i & 3], oT[i >> 2]); \
            __builtin_amdgcn_sched_barrier(0); \
        } } while (0)
    f32x16 S0, S1; float ps;
    int stg = 0;
    asm volatile("s_waitcnt vmcnt(%0)" :: "n"(C::G) : "memory"); asm volatile("s_waitcnt lgkmcnt(0)" ::: "memory");
    __builtin_amdgcn_s_barrier();
    ps = 0.f;
    QK_HALF(S0, 0, 0, false, S1, 0);
    MASKH(S0, 0, 0);
    QK_HALF(S1, 1, 0, true, S0, 0);
    l_run += ps;
    for (int j = 0; j < NT; ++j) {
        asm volatile("s_waitcnt vmcnt(0)" ::: "memory"); asm volatile("s_waitcnt lgkmcnt(0)" ::: "memory");
        __builtin_amdgcn_s_barrier();
        const int s1 = stg == 2 ? 0 : stg + 1;
        if (j + 2 < NT) { const int s2 = stg >= 1 ? stg - 1 : 2; ATT_DMA(s2); }
        MASKH(S1, j, 1);
        ps = 0.f;
        if (j + 1 < NT) { QK_HALF(S0, 0, s1, true, S1, 2); }
        else {
#pragma unroll
            for (int c = 0; c < 8; ++c) SMCH(S1, c, 2); }
        l_run += ps;
        PV_TILE(stg);
        if (j + 1 < NT) { MASKH(S0, j + 1, 0); ps = 0.f; QK_HALF(S1, 1, s1, true, S0, 0); l_run += ps; }
        stg = s1;
    }
    asm volatile("s_waitcnt lgkmcnt(0)" ::: "memory");
    __builtin_amdgcn_s_barrier();
    { float l = l_run; l += __shfl_xor(l, 32);
      const float il = (F8_P4 ? F8_SX : 1.0f) / l; unsigned char* orow = P.O + (size_t)(qw0 + r32) * P.op + (F8_P4 ? 4 : 8) * hi;
#pragma unroll
      for (int d0 = 0; d0 < 4; ++d0)
#pragma unroll
          for (int g = 0; g < 4; ++g) { const f32x4 ov = (f32x4){oT[d0][4 * g] * il, oT[d0][4 * g + 1] * il, oT[d0][4 * g + 2] * il, oT[d0][4 * g + 3] * il};
              if (F8_P4) *(unsigned*)(orow + 32 * d0 + 8 * g) = pk4_fp8(ov); else *(u32x2*)(orow + 64 * d0 + 16 * g) = pk4(ov); } }
#undef ATT_DMA
#undef KRD1
#undef VTR2
#undef SMCH
#undef QK_HALF
#undef MASKH
#undef PV_TILE
}
__device__ __forceinline__ void attn_unit_fox_pipe(const AttnPtrs& P, int qb, char* lds_, const float MB) {
    typedef AttnCfg<false> C;
    const LAS char* lds = (const LAS char*)lds_;
    int tid = threadIdx.x; asm volatile("" : "+v"(tid));
    const int lane = tid & 63, wid = __builtin_amdgcn_readfirstlane(tid >> 6), r32 = lane & 31, hi = lane >> 5;
    const int q0 = qb * C::UR, qw0 = q0 + 64 * wid, NT = (q0 + C::UR) / C::KT;
    bf16x8 qf[2][4]; float cq[2];
#pragma unroll
    for (int qi = 0; qi < 2; ++qi) { const bf16_t* qr = P.Q + (size_t)(qw0 + 32 * qi + r32) * P.qp + 8 * hi;
#pragma unroll
      for (int d0 = 0; d0 < 4; ++d0) qf[qi][d0] = *(const bf16x8*)(qr + 16 * d0);
      cq[qi] = -MB + P.F2[qw0 + 32 * qi + r32]; }
#pragma unroll
    for (int qi = 0; qi < 2; ++qi) {
#pragma unroll
        for (int d0 = 0; d0 < 4; ++d0) asm volatile("" : "+v"(qf[qi][d0]));
        asm volatile("" : "+v"(cq[qi])); }
    int t0 = 0;
    { const float fk = (lane < NT) ? P.F2[C::KT * lane + C::KT - 1] : 0.f; const float fq0 = P.F2[q0];
      const unsigned long long m = __ballot((lane < NT) && (fq0 - fk >= -160.0f)); t0 = __builtin_amdgcn_readfirstlane(m ? (int)__builtin_ctzll(m) : 0); }
    int koff[C::NKC], voff[C::NVC];
#pragma unroll
    for (int i = 0; i < C::NKC; ++i) { const int u = (wid + 8 * i) * 64 + lane, row = u / C::KCH, cp = u % C::KCH, c = cp ^ ((row >> 1) & 7); koff[i] = (row * P.k1p + c * 8) * 2; }
#pragma unroll
    for (int i = 0; i < C::NVC; ++i) { const int u = (wid + 8 * i) * 64 + lane, row = u / C::VCH, cp = u % C::VCH, c = cp ^ (((row >> 1) & 1) << 2); voff[i] = (row * P.vp + c * 8) * 2; }
    const int kstep = C::KT * P.k1p * 2, vstep = C::KT * P.vp * 2;
    int boff = lane * 16 + t0 * C::KT * 4;
#pragma unroll
    for (int i = 0; i < C::NKC; ++i) koff[i] += t0 * kstep;
#pragma unroll
    for (int i = 0; i < C::NVC; ++i) voff[i] += t0 * vstep;
#define ATT_DMA(stg) do { \
        _Pragma("unroll") for (int i = 0; i < C::NKC; ++i) { __builtin_amdgcn_global_load_lds((const unsigned*)((const char*)P.K1 + koff[i]), (LAS unsigned*)(lds_ + (stg) * C::STAGE + (wid + 8 * i) * 1024), 16, 0, 0); koff[i] += kstep; } \
        _Pragma("unroll") for (int i = 0; i < C::NVC; ++i) { __builtin_amdgcn_global_load_lds((const unsigned*)((const char*)P.V + voff[i]), (LAS unsigned*)(lds_ + (stg) * C::STAGE + C::KBUF + (wid + 8 * i) * 1024), 16, 0, 0); voff[i] += vstep; } \
        __builtin_amdgcn_global_load_lds((const unsigned*)((const char*)P.F2 + boff), (LAS unsigned*)(lds_ + (stg) * C::STAGE + C::KBUF + C::VBUF), 16, 0, 0); boff += C::KT * 4; } while (0)
    ATT_DMA(0); ATT_DMA(1);
    f32x16 oT[2][2];
#pragma unroll
    for (int qi = 0; qi < 2; ++qi)
#pragma unroll
        for (int d0 = 0; d0 < 2; ++d0)
#pragma unroll
            for (int r = 0; r < 16; ++r) oT[qi][d0][r] = 0.f;
    float l_run[2] = {0.f, 0.f};
    int kb4[4];
#pragma unroll
    for (int j = 0; j < 4; ++j) kb4[j] = r32 * C::KS + (((2 * j + hi) ^ ((r32 >> 1) & 7)) * 16);
    const int vq = (lane & 15) >> 2;
    int vb4[2];
#pragma unroll
    for (int d0 = 0; d0 < 2; ++d0) vb4[d0] = C::KBUF + (4 * hi + vq) * C::VS + ((d0 ^ (vq >> 1)) * 64) + ((lane >> 4) & 1) * 32 + (lane & 3) * 8;
    constexpr int PFK = 1, PFV = 2;
    bf16x8 kf[PFK + 1][2]; unsigned kaddr[4]; s16x4 vl[PFV + 1], vh[PFV + 1]; unsigned vaddr[2]; bf16x8 pb[2][4]; float ps;
#define KRD2(slot, d) do { asm volatile("ds_read_b128 %0, %1 offset:%2" : "=v"(kf[slot][0]) : "v"(kaddr[(d) & 3]), "n"(0)); \
                           asm volatile("ds_read_b128 %0, %1 offset:%2" : "=v"(kf[slot][1]) : "v"(kaddr[(d) & 3]), "n"(32 * C::KS)); } while (0)
#define VTR2(slot, n) do { asm volatile("ds_read_b64_tr_b16 %0, %1 offset:%2" : "=v"(vl[slot]) : "v"(vaddr[(n) >> 2]), "n"(((n) & 3) * 16 * C::VS)); \
                           asm volatile("ds_read_b64_tr_b16 %0, %1 offset:%2" : "=v"(vh[slot]) : "v"(vaddr[(n) >> 2]), "n"(((n) & 3) * 16 * C::VS + 8 * C::VS)); } while (0)
#define SMCH(T0, T1, c, NE, PB) do { \
        _Pragma("unroll") for (int e_ = (NE) * (c); e_ < (NE) * (c) + (NE); ++e_) { if (e_ < 16) { T0[e_] = __builtin_amdgcn_exp2f(T0[e_]); ps += T0[e_]; } else { T1[e_ - 16] = __builtin_amdgcn_exp2f(T1[e_ - 16]); ps += T1[e_ - 16]; } } \
        if ((((NE) * ((c) + 1)) & 7) == 0) { const int s_ = ((NE) * ((c) + 1)) / 8 - 1; u32x4 w_; \
            if (s_ < 2) { w_.x = cvtpk(T0[8 * s_ + 0], T0[8 * s_ + 1]); w_.y = cvtpk(T0[8 * s_ + 2], T0[8 * s_ + 3]); w_.z = cvtpk(T0[8 * s_ + 4], T0[8 * s_ + 5]); w_.w = cvtpk(T0[8 * s_ + 6], T0[8 * s_ + 7]); } \
            else { w_.x = cvtpk(T1[8 * (s_ - 2) + 0], T1[8 * (s_ - 2) + 1]); w_.y = cvtpk(T1[8 * (s_ - 2) + 2], T1[8 * (s_ - 2) + 3]); w_.z = cvtpk(T1[8 * (s_ - 2) + 4], T1[8 * (s_ - 2) + 5]); w_.w = cvtpk(T1[8 * (s_ - 2) + 6], T1[8 * (s_ - 2) + 7]); } \
            PB[s_] = __builtin_bit_cast(bf16x8, w_); } } while (0)
#define QK_BLK(S0, S1, QI, DOSM, T0, T1, PB) do { \
        asm volatile("s_waitcnt lgkmcnt(0)" ::: "memory"); \
        KRD2(0, 0); \
        _Pragma("unroll") for (int d0 = 0; d0 < 4; ++d0) { \
            if (d0 + 1 < 4) { KRD2((d0 + 1) & 1, d0 + 1); asm volatile("s_waitcnt lgkmcnt(2)" ::: "memory"); } else asm volatile("s_waitcnt lgkmcnt(0)" ::: "memory"); \
            __builtin_amdgcn_sched_barrier(0); \
            S0 = mfma32(kf[d0 & 1][0], qf[QI][d0], S0); S1 = mfma32(kf[d0 & 1][1], qf[QI][d0], S1); \
            __builtin_amdgcn_sched_barrier(0); \
            if (DOSM) { SMCH(T0, T1, d0, 8, PB); __builtin_amdgcn_sched_barrier(0); } \
        } } while (0)
#define PV_BLK(QI, PBU, DOSM, T0, T1, PB) do { \
        asm volatile("s_waitcnt lgkmcnt(0)" ::: "memory"); \
        _Pragma("unroll") for (int i = 0; i < PFV; ++i) VTR2(i, i); \
        _Pragma("unroll") for (int i = 0; i < 8; ++i) { \
            if (i + PFV < 8) { VTR2((i + PFV) % (PFV + 1), i + PFV); asm volatile("s_waitcnt lgkmcnt(%0)" :: "n"(2 * PFV) : "memory"); } \
            else asm volatile("s_waitcnt lgkmcnt(%0)" :: "n"(2 * (7 - i)) : "memory"); \
            __builtin_amdgcn_sched_barrier(0); \
            { const s16x4 lo = vl[i % (PFV + 1)], hh = vh[i % (PFV + 1)]; \
              const bf16x8 vf = (bf16x8){lo[0], lo[1], lo[2], lo[3], hh[0], hh[1], hh[2], hh[3]}; \
              oT[QI][i >> 2] = mfma32(vf, PBU[i & 3], oT[QI][i >> 2]); } \
            __builtin_amdgcn_sched_barrier(0); \
            if (DOSM) { SMCH(T0, T1, i, 4, PB); __builtin_amdgcn_sched_barrier(0); } \
        } } while (0)
#define MASKQ(T0, T1, QI) do { const int qwi_ = qw0 + 32 * (QI); if (kb + 63 > qwi_) { const int dq = qwi_ + r32 - kb - 4 * hi; \
        _Pragma("unroll") for (int r = 0; r < 16; ++r) { const int c = (r & 3) + 8 * (r >> 2); if (c > dq) T0[r] = -__builtin_inff(); if (c + 32 > dq) T1[r] = -__builtin_inff(); } } } while (0)
    int stg = 0;
    for (int t = t0; t < NT; ++t) {
        if (t + 1 < NT) asm volatile("s_waitcnt vmcnt(%0)" :: "n"(C::G) : "memory"); else asm volatile("s_waitcnt vmcnt(0)" ::: "memory");
        asm volatile("s_waitcnt lgkmcnt(0)" ::: "memory");
        __builtin_amdgcn_s_barrier();
        if (t + 2 < NT) { const int s2 = stg >= 1 ? stg - 1 : 2; ATT_DMA(s2); }
        const LAS char* sbase = lds + stg * C::STAGE;
#pragma unroll
        for (int sub = 0; sub < 2; ++sub) {
            const int kb = t * C::KT + 64 * sub;
            if (kb > qw0 + 63) continue;
            const LAS char* sk = sbase + sub * 64 * C::KS; const LAS char* sv = sbase + sub * 64 * C::VS;
            f32x16 pa0, pa1, pc0, pc1;
#pragma unroll
            for (int g = 0; g < 4; ++g) { const f32x4 b0 = *(const LAS f32x4*)(sbase + C::KBUF + C::VBUF + (64 * sub + 8 * g + 4 * hi) * 4), b1 = *(const LAS f32x4*)(sbase + C::KBUF + C::VBUF + (64 * sub + 32 + 8 * g + 4 * hi) * 4);
#pragma unroll
                for (int j = 0; j < 4; ++j) { pa0[4 * g + j] = cq[0] - b0[j]; pa1[4 * g + j] = cq[0] - b1[j]; pc0[4 * g + j] = cq[1] - b0[j]; pc1[4 * g + j] = cq[1] - b1[j]; } }
#pragma unroll
            for (int j = 0; j < 4; ++j) kaddr[j] = (unsigned)(uintptr_t)(sk + kb4[j]);
#pragma unroll
            for (int d0 = 0; d0 < 2; ++d0) vaddr[d0] = (unsigned)(uintptr_t)(sv + vb4[d0]);
            QK_BLK(pa0, pa1, 0, false, pc0, pc1, pb[1]);
            MASKQ(pa0, pa1, 0);
            ps = 0.f; QK_BLK(pc0, pc1, 1, true, pa0, pa1, pb[0]); l_run[0] += ps;
            MASKQ(pc0, pc1, 1);
            ps = 0.f; PV_BLK(0, pb[0], true, pc0, pc1, pb[1]); l_run[1] += ps;
            PV_BLK(1, pb[1], false, pa0, pa1, pb[0]);
        }
        stg = stg == 2 ? 0 : stg + 1;
    }
    asm volatile("s_waitcnt lgkmcnt(0)" ::: "memory");
    __builtin_amdgcn_s_barrier();
#pragma unroll
    for (int qi = 0; qi < 2; ++qi) {
        float l = l_run[qi]; l += __shfl_xor(l, 32);
        const float il = (F8_P4 ? F8_SX : 1.0f) / l; unsigned char* orow = P.O + (size_t)(qw0 + 32 * qi + r32) * P.op + (F8_P4 ? 4 : 8) * hi;
#pragma unroll
        for (int d0 = 0; d0 < 2; ++d0)
#pragma unroll
            for (int g = 0; g < 4; ++g) { const f32x4 ov = (f32x4){oT[qi][d0][4 * g] * il, oT[qi][d0][4 * g + 1] * il, oT[qi][d0][4 * g + 2] * il, oT[qi][d0][4 * g + 3] * il};
                if (F8_P4) *(unsigned*)(orow + 32 * d0 + 8 * g) = pk4_fp8(ov); else *(u32x2*)(orow + 64 * d0 + 16 * g) = pk4(ov); }
    }
#undef ATT_DMA
#undef KRD2
#undef VTR2
#undef SMCH
#undef QK_BLK
#undef PV_BLK
#undef MASKQ
}
__device__ __forceinline__ float absmax_vec(const float* g, int n) { float m = 0.f; for (int i = 0; i < n; ++i) m = fmaxf(m, fabsf(g[i])); return m; }
template <bool MLA, int VAR = 0>
__device__ __forceinline__ void attn_phase_fast(const Args& a, char* lds, int qslot = 0) {
    unsigned char* ws = a.ws; constexpr int NH = MLA ? 8 : 16; constexpr int NQB = SEQ / AttnCfg<MLA>::UR, NPAIR = NQB / 2; constexpr int NITEMS = BATCH * NH * NPAIR;
    float MB;
    if (MLA) MB = C2_MLA * (128.f * absmax_vec(a.in[8], 128) * absmax_vec(a.in[10], 128) + 64.f * absmax_vec(a.in[9], 64) * absmax_vec(a.in[11], 64));
    else MB = C2_FOX * 64.f * absmax_vec(a.in[12], 64) * absmax_vec(a.in[13], 64);
    MB = MB * 1.02f + 0.25f;
    MB = __builtin_bit_cast(float, __builtin_amdgcn_readfirstlane(__builtin_bit_cast(int, MB)));
    if (!MLA) {
        int* qctr = (int*)(ws + WS_CTL) + 64 + qslot; volatile int* lq = (volatile int*)(lds + LDS_BYTES - 32);
        constexpr int NUNITS = BATCH * NH * NQB;
        for (;;) {
            if (threadIdx.x == 0) lq[0] = atomicAdd(qctr, 1);
            __syncthreads();
            const int u = __builtin_amdgcn_readfirstlane(lq[0]);
            __syncthreads();
            if (u >= NUNITS) break;
            const int qb = NQB - 1 - u / (BATCH * NH), bh = u % (BATCH * NH), b = bh / NH, h = bh % NH;
            const size_t rb = (size_t)b * SEQ; AttnPtrs P; const bf16_t* Z = (const bf16_t*)(ws + WS_Z) + rb * ZP;
            P.Q = Z + OFF_FQ + h * 64; P.qp = ZP; P.K1 = Z + OFF_FK + h * 64; P.k1p = ZP; P.K2 = nullptr; P.k2p = 0; P.V = Z + OFF_FV + h * 64; P.vp = ZP;
            P.O = (unsigned char*)(ws + WS_OF) + (rb * 1024 + h * 64) * (F8_P4 ? 1 : 2); P.op = F8_P4 ? 1024 : 2048; P.F2 = (const float*)(ws + WS_FC) + ((size_t)b * 16 + h) * SEQ;
#if ATT_F8
            if (VAR == 0) { AttnPtrs8 P8; P8.Q = (const unsigned char*)(ws + WS_FQ8) + rb * 1024 + h * 64; P8.qp = 1024; P8.K1 = (const unsigned char*)(ws + WS_FK8) + rb * 1024 + h * 64; P8.k1p = 1024; P8.K2 = nullptr; P8.k2p = 0;
                P8.V = P.V; P8.vp = P.vp; P8.O = P.O; P8.op = P.op; P8.F2 = P.F2; P8.FR = ws + WS_FCR + (((size_t)b * 16 + h) * SEQ) * 16; attn_unit8<false>(P8, qb, lds, MB); } else
#elif FOX_PIPE
            if (VAR == 0) attn_unit_fox_pipe(P, qb, lds, MB); else
#endif
            attn_unit<MLA, VAR>(P, qb, lds, MB);
        }
    } else {
    for (int L = blockIdx.x; L < NITEMS; L += gridDim.x) {
        const int xcd = L & 7, n = L >> 3, bhl = n / NPAIR, pair = n % NPAIR, bh = xcd + 8 * bhl, b = bh / NH, h = bh % NH;
        const size_t rb = (size_t)b * SEQ; AttnPtrs P;
        { const bf16_t* KVM = (const bf16_t*)(ws + WS_KVM);
            P.Q = (const bf16_t*)(ws + WS_QM) + rb * 1536 + h * 192; P.qp = 1536; P.K1 = KVM + rb * 2048 + h * 256; P.k1p = 2048; P.K2 = (const bf16_t*)(ws + WS_KR) + rb * 64; P.k2p = 64;
            P.V = KVM + rb * 2048 + h * 256 + 128; P.vp = 2048; P.O = (unsigned char*)(ws + WS_OM) + (rb * 1024 + h * 128) * (F8_P4 ? 1 : 2); P.op = F8_P4 ? 1024 : 2048; P.F2 = nullptr; }
#if ATT_F8
        if (VAR == 0) { AttnPtrs8 P8; P8.Q = (const unsigned char*)(ws + WS_QM8) + rb * 1536 + h * 192; P8.qp = 1536; P8.K1 = (const unsigned char*)(ws + WS_K8) + rb * 1024 + h * 128; P8.k1p = 1024;
            P8.K2 = (const unsigned char*)(ws + WS_KR8) + rb * 64; P8.k2p = 64; P8.V = P.V; P8.vp = P.vp; P8.O = P.O; P8.op = P.op; P8.F2 = nullptr; P8.FR = nullptr;
            attn_unit8<true>(P8, NQB - 1 - pair, lds, MB); attn_unit8<true>(P8, pair, lds, MB); } else
#elif MLA_PIPE
        if (VAR == 0) { attn_unit_mla_pipe(P, NQB - 1 - pair, lds, MB); attn_unit_mla_pipe(P, pair, lds, MB); } else
#endif
        { attn_unit<MLA, VAR>(P, NQB - 1 - pair, lds, MB);
        attn_unit<MLA, VAR>(P, pair, lds, MB); }
    }
    }
}

__device__ __forceinline__ void phase_router(const Args& a, char* lds, int wave, int lane) {
    unsigned char* ws = a.ws; const int tid = threadIdx.x;
    int* sel_e = (int*)lds;
    float* sel_g = (float*)(lds + 2048);
    int* rnk = (int*)(lds + 4096);
    int* lcnt = (int*)(lds + 6144);
    int* lbase = lcnt + 32;
    float* sel_r = (float*)(lbase + 32);
    const bf16_t* X1B = (const bf16_t*)(ws + WS_X1B); float* RSTD2 = (float*)(ws + WS_RSTD2); const bf16_t* WR3 = (const bf16_t*)(ws + WS_WR3);
    const float* b_router = a.in[20];
    int* CNT = (int*)(ws + WS_CTL); int* LIST = (int*)(ws + WS_LIST); float* GATE = (float*)(ws + WS_GATE);
    unsigned char* X1F8 = (unsigned char*)(ws + WS_X1F8);
    if (blockIdx.x == 0) { if (tid < 64) *((u32x4*)(X1F8 + (size_t)NTOK * DM) + tid) = (u32x4){0u, 0u, 0u, 0u}; if (tid == 0) RSTD2[NTOK] = 0.f; }
    const int r32 = lane & 31, hi = lane >> 5;
    for (int chunk = blockIdx.x; chunk < NTOK / 128; chunk += gridDim.x) {
        if (tid < 32) lcnt[tid] = 0;
        if (wave < 4) {
            const int lt = 32 * wave + r32, t = chunk * 128 + lt;
            const bf16_t* xr = X1B + (size_t)t * DM + 8 * hi; const bf16_t* wrow = WR3 + (size_t)r32 * 1024 + 8 * hi;
            f32x16 C;
#pragma unroll
            for (int r = 0; r < 16; ++r) C[r] = 0.f;
            float ss = 0.f;
#pragma unroll 4
            for (int k0 = 0; k0 < 1024; k0 += 16) {
                const u32x4 xw = *(const u32x4*)(xr + k0);
                { const f32x4 a0 = unpk4((u32x2){xw.x, xw.y}), a1 = unpk4((u32x2){xw.z, xw.w}); ss += (a0[0] * a0[0] + a0[1] * a0[1]) + (a0[2] * a0[2] + a0[3] * a0[3]) + (a1[0] * a1[0] + a1[1] * a1[1]) + (a1[2] * a1[2] + a1[3] * a1[3]);
                  *(u32x2*)(X1F8 + (size_t)t * DM + k0 + 8 * hi) = (u32x2){pk4_fp8s(a0 * F8_SX), pk4_fp8s(a1 * F8_SX)}; }
                const bf16x8 xb = __builtin_bit_cast(bf16x8, xw);
#pragma unroll
                for (int tm = 0; tm < 3; ++tm) { const bf16x8 wf = *(const bf16x8*)(wrow + tm * 32768 + k0); C = mfma32(wf, xb, C); }
            }
            ss += __shfl_xor(ss, 32);
            const float rs = __builtin_amdgcn_rsqf(ss * (1.0f / DM) + EPS);
            float t0 = -3.0e38f, t1 = -3.0e38f, t2 = -3.0e38f, t3 = -3.0e38f; int i0 = 0, i1 = 0, i2 = 0, i3 = 0;
#define TOPINS(x, e) do { const float x_ = (x); const int e_ = (e); \
                if (x_ > t3 || (x_ == t3 && e_ < i3)) { if (x_ > t2 || (x_ == t2 && e_ < i2)) { t3 = t2; i3 = i2; if (x_ > t1 || (x_ == t1 && e_ < i1)) { t2 = t1; i2 = i1; if (x_ > t0 || (x_ == t0 && e_ < i0)) { t1 = t0; i1 = i0; t0 = x_; i0 = e_; } else { t1 = x_; i1 = e_; } } else { t2 = x_; i2 = e_; } } else { t3 = x_; i3 = e_; } } } while (0)
#pragma unroll
            for (int r = 0; r < 16; ++r) { const int e = (r & 3) + 8 * (r >> 2) + 4 * hi; TOPINS(C[r] * rs + b_router[e], e); }
            { const float p0 = __shfl_xor(t0, 32), p1 = __shfl_xor(t1, 32), p2 = __shfl_xor(t2, 32), p3 = __shfl_xor(t3, 32);
              const int q0 = __shfl_xor(i0, 32), q1 = __shfl_xor(i1, 32), q2 = __shfl_xor(i2, 32), q3 = __shfl_xor(i3, 32);
              TOPINS(p0, q0); TOPINS(p1, q1); TOPINS(p2, q2); TOPINS(p3, q3); }
#undef TOPINS
            const float e1 = __expf(t1 - t0), e2 = __expf(t2 - t0), e3 = __expf(t3 - t0), inv = 1.0f / (1.0f + e1 + e2 + e3);
            if (hi == 0) { RSTD2[t] = rs; sel_r[lt] = rs;
                sel_e[lt * 4 + 0] = i0; sel_e[lt * 4 + 1] = i1; sel_e[lt * 4 + 2] = i2; sel_e[lt * 4 + 3] = i3;
                sel_g[lt * 4 + 0] = inv; sel_g[lt * 4 + 1] = e1 * inv; sel_g[lt * 4 + 2] = e2 * inv; sel_g[lt * 4 + 3] = e3 * inv; }
        }
        __syncthreads();
        const int my_e = sel_e[tid]; rnk[tid] = atomicAdd(&lcnt[my_e], 1);
        __syncthreads();
        if (tid < 32) lbase[tid] = atomicAdd(&CNT[tid], lcnt[tid]);
        __syncthreads();
        { const int pos = lbase[my_e] + rnk[tid]; const size_t sl = (size_t)my_e * NTOK + pos; LIST[sl] = chunk * 512 + tid; GATE[chunk * 512 + tid] = sel_g[tid];
          ((float*)(ws + WS_LISTR))[sl] = sel_r[tid >> 2]; ((float*)(ws + WS_LISTG))[sl] = sel_g[tid]; }
        __syncthreads();
    }
}

struct GatherRows { const bf16_t* X; const int* list; int idx0, cnt; __device__ __forceinline__ const bf16_t* operator()(int r) const { const int idx = idx0 + r; const int tok = idx < cnt ? (list[idx] >> 2) : NTOK; return X + (size_t)tok * DM; } };
__device__ __forceinline__ int moe_table(const int* CNT, int* tstart  , int* cnts  ) {
    if (threadIdx.x < 64) {
        const int e = threadIdx.x; const int c = (e < NEXP) ? CNT[e] : 0; const int nt = (c + 255) >> 8; int incl = nt;
#pragma unroll
        for (int o = 1; o < 32; o <<= 1) { const int u = __shfl_up(incl, o); if ((e & 63) >= o) incl += u; }
        if (e < NEXP) { cnts[e] = c; tstart[e] = incl - nt; }
        if (e == NEXP - 1) tstart[NEXP] = incl;
    }
    __syncthreads();
    int* tile_e = tstart + 128;
    int t_first = threadIdx.x; asm volatile("" : "+v"(t_first));
    for (int t = t_first; t < tstart[NEXP]; t += NTHREADS) { int e = 0; for (int q = 1; q < NEXP; ++q) if (t >= tstart[q]) e = q; tile_e[t] = e; }
    __syncthreads();
    return tstart[NEXP];
}
template <bool UP, class Epi>
__device__ __forceinline__ void moe_gemm_simple(const Args& a, char* lds, const Epi& E, int wave, int lane) {
    unsigned char* ws = a.ws; int* tstart = (int*)lds; int* cnts = tstart + 64;
    const int T = moe_table((const int*)(ws + WS_CTL), tstart, cnts);
    constexpr int NPN = UP ? 8 : 4;
    const int* LIST = (const int*)(ws + WS_LIST);
    for (int u = blockIdx.x; u < T * NPN; u += gridDim.x) {
        const int t = u / NPN, pn = u % NPN; int e = 0;
        for (int q = 1; q < NEXP; ++q) if (t >= tstart[q]) e = q;
        UnitCtx uc; uc.row0 = t * 256; uc.e = e; uc.idx0 = (t - tstart[e]) * 256; uc.cnt = cnts[e]; uc.list = LIST + (size_t)e * NTOK;
        if (UP) { GatherRows RP{(const bf16_t*)(ws + WS_X1B), uc.list, uc.idx0, uc.cnt};
            gemm_unit_simple(RP, (const bf16_t*)(ws + WS_WUP) + ((size_t)e * 2048 + pn * 256) * 1024, 1024, 1024, pn * 256, uc, E, wave, lane); }
        else { DenseRows RP{(const bf16_t*)(ws + WS_H) + (size_t)t * 256 * EFF, EFF};
            gemm_unit_simple(RP, (const bf16_t*)(ws + WS_WDOWN) + ((size_t)e * 1024 + pn * 256) * 1024, 1024, 1024, pn * 256, uc, E, wave, lane); }
    }
}


template <bool UP> struct MoeSched { const char* Abase; const char* Wbase; const int* tstart; const int* cnts; const int* LIST; pg8::StaticOrder so;
    __device__ __forceinline__ bool next(int i, pg8::GUnit& u) const { pg8::Unit t; if (!so.next(i, t)) return false;
        const int e = __builtin_amdgcn_readfirstlane(tstart[128 + t.pm]);
        u.uc.row0 = t.pm * 256; u.uc.e = e; u.uc.idx0 = (t.pm - __builtin_amdgcn_readfirstlane(tstart[e])) * 256; u.uc.cnt = __builtin_amdgcn_readfirstlane(cnts[e]); u.uc.list = LIST + (size_t)e * NTOK; u.colbase = t.pn * 256;
        if (UP) { u.A = Abase; u.B = Wbase + ((size_t)e * 2048 + t.pn * 256) * 1024; }
        else { u.A = Abase + (size_t)t.pm * 256 * EFF; u.B = Wbase + ((size_t)e * 1024 + t.pn * 256) * 1024; }
        return true; }
    __device__ __forceinline__ void gather_offsets(const pg8::GUnit& u, const int (&Rr)[2], const int (&Cc)[2], unsigned (&off)[2][2], int RB) const {
#pragma unroll
        for (int h = 0; h < 2; ++h)
#pragma unroll
            for (int i = 0; i < 2; ++i) { const int idx = u.uc.idx0 + Rr[i] + 128 * h; const int tok = idx < u.uc.cnt ? (u.uc.list[idx] >> 2) : NTOK; off[h][i] = (unsigned)tok * (unsigned)RB + (unsigned)Cc[i] * 2u; }
    }
};
template <bool UP, class Epi>
__device__ __forceinline__ void moe_gemm_fast(const Args& a, char* lds, const Epi& E) {
    unsigned char* ws = a.ws; int* tstart = (int*)(lds + 131072); int* cnts = tstart + 64;
    const int T = moe_table((const int*)(ws + WS_CTL), tstart, cnts);
    MoeSched<UP> S; S.Abase = UP ? (const char*)(ws + WS_X1F8) : (const char*)(ws + WS_H); S.Wbase = UP ? (const char*)(ws + WS_WUP) : (const char*)(ws + WS_WDOWN);
    S.tstart = tstart; S.cnts = cnts; S.LIST = (const int*)(ws + WS_LIST); S.so.init(T, UP ? 8 : 4, (int)gridDim.x, (int)blockIdx.x, UP ? WGM_UP : WGM_DOWN);
    pg8::gemm_phase<Epi, MoeSched<UP>, UP, true>((LAS unsigned char*)lds, 1024, S, E);
}

__device__ __forceinline__ void phase_combine(const Args& a, int gw, int ngw, int lane) {
    unsigned char* ws = a.ws; const bf16_t* X1B = (const bf16_t*)(ws + WS_X1B); const bf16_t* Y = (const bf16_t*)(ws + WS_Y); bf16_t* X2B = (bf16_t*)(ws + WS_X2B); float* RSTD3 = (float*)(ws + WS_RSTD3);
    for (int t = gw; t < NTOK; t += ngw) {
        float ss = 0.f; f32x4 v[4];
#pragma unroll
        for (int j = 0; j < 4; ++j) { f32x4 y = (f32x4){0.f, 0.f, 0.f, 0.f};
#pragma unroll
            for (int k = 0; k < 4; ++k) y = y + unpk4(*((const u32x2*)(Y + ((size_t)t * 4 + k) * DM) + lane + 64 * j));
            v[j] = unpk4(*((const u32x2*)(X1B + (size_t)t * DM) + lane + 64 * j)) + y; ss += (v[j][0] * v[j][0] + v[j][1] * v[j][1]) + (v[j][2] * v[j][2] + v[j][3] * v[j][3]); }
        ss = wave_sum(ss);
        if (lane == 0) RSTD3[t] = __builtin_amdgcn_rsqf(ss * (1.0f / DM) + EPS);
        u32x2* xb = (u32x2*)(X2B + (size_t)t * DM) + lane; unsigned* x8 = (unsigned*)(ws + WS_X2F8 + (size_t)t * DM) + lane;
#pragma unroll
        for (int j = 0; j < 4; ++j) { xb[64 * j] = pk4(v[j]); x8[64 * j] = pk4_fp8s(v[j] * F8_SX); }
    }
}

#ifndef FAST_MLA
#define FAST_MLA 1
#endif
#ifndef FAST_FOX
#define FAST_FOX 1
#endif
#ifndef FAST_MOE
#define FAST_MOE 1
#endif
#if FAST_MOE
#define MOE_GEMM(UP_, E_) moe_gemm_fast<UP_>(a, lds, E_)
#else
#define MOE_GEMM(UP_, E_) moe_gemm_simple<UP_>(a, lds, E_, wave, lane)
#endif
#ifndef FAST_DENSE
#define FAST_DENSE 1
#endif
#if FAST_DENSE
#define GEMM_DENSE(A_, lda_, Bt_, M_, N_, K_, E_) gemm_dense_fast(lds, A_, Bt_, M_, N_, K_, E_)
#define GEMM_DENSE8(A_, Bt_, M_, N_, K_, E_) gemm_dense_fast<decltype(E_), true>(lds, A_, Bt_, M_, N_, K_, E_)
#else
#define GEMM_DENSE(A_, lda_, Bt_, M_, N_, K_, E_) gemm_dense(A_, lda_, Bt_, M_, N_, K_, E_, wave, lane)
#endif
#define XB_TMO      128
#define XB_XCNT(j)  (256  + 64 * (j))
#define XB_XSUB(j)  (1280 + 64 * (j))
#define XB_XGEN(j)  (2304 + 64 * (j))
#define XB_TOP      3328
#define XB_TOPGEN   3392
#define XCD_BAR_WORDS 3456
#define XB_SPIN_CAP (1u << 22)
__device__ __forceinline__ unsigned xb_ld(unsigned* p)              { return __hip_atomic_load(p, __ATOMIC_RELAXED, __HIP_MEMORY_SCOPE_AGENT); }
__device__ __forceinline__ unsigned xb_add(unsigned* p, unsigned v) { return __hip_atomic_fetch_add(p, v, __ATOMIC_RELAXED, __HIP_MEMORY_SCOPE_AGENT); }
__device__ __forceinline__ unsigned xb_xcc_id() { return (unsigned)__builtin_amdgcn_s_getreg((3 << 11) | 20) & 0xFu; }
#define XB_SPIN(cond, bar) do { unsigned _sp = 0; while (cond) { __builtin_amdgcn_s_sleep(1); \
    if ((++_sp & 255u) == 0u) { if (xb_ld(&(bar)[XB_TMO])) break; if (_sp > XB_SPIN_CAP) { atomicAdd(&(bar)[XB_TMO], 1u); break; } } } } while (0)
struct XcdBarrier { unsigned* bar; unsigned x; volatile LAS unsigned* st; };
__device__ __forceinline__ XcdBarrier xcd_barrier_post(unsigned* bar, volatile LAS unsigned* st) {
    XcdBarrier b; b.bar = bar; b.x = xb_xcc_id(); b.st = st;
    if (threadIdx.x == 0) (void)xb_add(&bar[XB_XCNT(b.x)], 1u);
    return b;
}
__device__ __forceinline__ void xcd_barrier_complete(unsigned* bar, unsigned x, unsigned& nloc, unsigned& nx) {
    const unsigned G = gridDim.x * gridDim.y * gridDim.z;
    unsigned sum, cnt, mine, sp = 0u;
    for (;;) {
        sum = 0u; cnt = 0u; mine = 0u;
#pragma unroll
        for (unsigned j = 0; j < 16; ++j) { const unsigned c = xb_ld(&bar[XB_XCNT(j)]); sum += c; cnt += (c > 0u) ? 1u : 0u; mine = (j == x) ? c : mine; }
        if (sum == G) break;
        __builtin_amdgcn_s_sleep(1);
        if ((++sp & 255u) == 0u) { if (xb_ld(&bar[XB_TMO])) break; if (sp > XB_SPIN_CAP) { atomicAdd(&bar[XB_TMO], 1u); break; } }
    }
    nloc = mine > 0u ? mine : 1u; nx = cnt > 0u ? cnt : 1u;
}
__device__ __forceinline__ void xcd_barrier(const XcdBarrier& b) {
    asm volatile("s_waitcnt vmcnt(0)" ::: "memory");
    __syncthreads();
    if (threadIdx.x == 0) {
        unsigned* bar = b.bar;
        __builtin_amdgcn_s_waitcnt(0);
        unsigned nloc = b.st[0], nx = b.st[1];
        if (nloc == 0u) { xcd_barrier_complete(bar, b.x, nloc, nx); b.st[0] = nloc; b.st[1] = nx; }
        const unsigned old = xb_add(&bar[XB_XSUB(b.x)], 1u);
        const unsigned gen = old / nloc;
        if (old + 1u == (gen + 1u) * nloc) {
            __builtin_amdgcn_fence(__ATOMIC_RELEASE, "agent");
            asm volatile("s_waitcnt vmcnt(0)" ::: "memory");
            const unsigned og = xb_add(&bar[XB_TOP], 1u);
            const unsigned tg = og / nx;
            if (og + 1u == (tg + 1u) * nx) xb_add(&bar[XB_TOPGEN], 1u);
            else XB_SPIN(xb_ld(&bar[XB_TOPGEN]) == tg, bar);
            __builtin_amdgcn_fence(__ATOMIC_ACQUIRE, "agent");
            xb_add(&bar[XB_XGEN(b.x)], 1u);
            asm volatile("s_waitcnt vmcnt(0)" ::: "memory");
        } else {
            XB_SPIN(xb_ld(&bar[XB_XGEN(b.x)]) == gen, bar);
            __builtin_amdgcn_fence(__ATOMIC_ACQUIRE, "agent");
            asm volatile("s_waitcnt vmcnt(0)" ::: "memory");
        }
    }
    __syncthreads();
}


#ifndef MFMA_BENCH
#define MFMA_BENCH 0
#endif
template <int NACC>
__device__ __forceinline__ void mfma_bench(unsigned char* ws, int lane) {
    f32x16 acc[NACC];
#pragma unroll
    for (int i = 0; i < NACC; ++i)
#pragma unroll
        for (int r = 0; r < 16; ++r) acc[i][r] = 0.f;
    bf16x8 a = (bf16x8){(short)lane, 1, 2, 3, 4, 5, 6, 7}, b = (bf16x8){1, (short)lane, 2, 3, 4, 5, 6, 7};
    asm volatile("" : "+v"(a), "+v"(b));
    for (int it = 0; it < 10000 / NACC; ++it) {
#pragma unroll
        for (int i = 0; i < NACC; ++i) acc[i] = mfma32(a, b, acc[i]);
    }
    float s = 0.f;
#pragma unroll
    for (int i = 0; i < NACC; ++i) s += acc[i][0] + acc[i][7];
    if (s == 123.456f) *(float*)(ws + WS_CTL + 60000) = s;
}
#ifndef SHADOW_P1
#define SHADOW_P1 0
#endif
#ifndef SHADOW_MLA
#define SHADOW_MLA 0
#endif
#ifndef SHADOW_FOX
#define SHADOW_FOX 0
#endif
#ifndef REP_ID
#define REP_ID -1
#endif
#ifndef REP_MASK
#define REP_MASK 0
#endif
#define NREP(id) (((REP_ID == (id)) || ((REP_MASK >> (id)) & 1)) ? 2 : 1)
__device__ __forceinline__ Args fresh_args() {
    typedef const __attribute__((address_space(4))) Args* CP; CP p = (CP)__builtin_amdgcn_kernarg_segment_ptr(); asm volatile("" : "+s"(p));
    Args r;
#pragma unroll
    for (int i = 0; i < 28; ++i) r.in[i] = p->in[i];
    r.out = p->out; r.ws = p->ws; return r;
}
#define FRESH() const Args a = fresh_args(); unsigned char* ws = a.ws; int tid_ = threadIdx.x; asm volatile("" : "+v"(tid_)); const int lane = tid_ & 63, wave = __builtin_amdgcn_readfirstlane(tid_ >> 6); const int gw = blockIdx.x * NWAVES + wave, ngw = gridDim.x * NWAVES; (void)lane; (void)wave; (void)gw; (void)ngw
__global__ void __launch_bounds__(NTHREADS, 2) fwd_megakernel(Args a_kernarg) {
    extern __shared__ __attribute__((aligned(16))) char lds[];
    cg::grid_group grid = cg::this_grid();
    grid.sync();
    const int tid = threadIdx.x;
    volatile LAS unsigned* bst = (volatile LAS unsigned*)(lds + LDS_BYTES - 64);
    if (tid < 16) bst[tid] = 0u;
    __syncthreads();
    (void)xcd_barrier_post((unsigned*)(a_kernarg.ws + WS_CTL) + 1024, bst);
#define GSYNC() do { const Args ab_ = fresh_args(); XcdBarrier xb_; xb_.bar = (unsigned*)(ab_.ws + WS_CTL) + 1024; xb_.x = xb_xcc_id(); xb_.st = (volatile LAS unsigned*)(lds + LDS_BYTES - 64); xcd_barrier(xb_); } while (0)

    for (int rep = 0; rep < NREP(0); ++rep) { { FRESH(); (void)ws; phase_prologue(a, lds, gw, ngw, wave, lane); }
    GSYNC(); }
    {   FRESH();
        EpiZHead E{(bf16_t*)(ws + WS_Z), (bf16_t*)(ws + WS_CQN), (bf16_t*)(ws + WS_CKVN), (bf16_t*)(ws + WS_KR), (unsigned char*)(ws + WS_KR8), (unsigned char*)(ws + WS_FQ8), (unsigned char*)(ws + WS_FK8), (float*)(ws + WS_LF), (const float*)(ws + WS_RSTD1), a.in[11], a.in[12], a.in[13], a.in[14], (const f32x2*)(ws + WS_ROPE)};
#if SHADOW_P1
        { EpiNull EN{(float*)(ws + WS_CTL + 61000)}; GEMM_DENSE((const bf16_t*)(ws + WS_XB), DM, (const bf16_t*)(ws + WS_WIN), NTOK, ZP, DM, EN); }
#endif
        for (int rep = 0; rep < NREP(1); ++rep) {
            if (!F8_P1) GEMM_DENSE((const bf16_t*)(ws + WS_XB), DM, (const bf16_t*)(ws + WS_WIN), NTOK, ZP, DM, E);
            else { if (P1_F8_TILE0 > 0) gemm_dense_fast(lds, ws + WS_XB, ws + WS_WIN, NTOK, 256 * P1_F8_TILE0, DM, E);
                   gemm_dense_fast<decltype(E), true>(lds, ws + WS_XF8, ws + WS_WIN8, NTOK, ZP - 256 * P1_F8_TILE0, DM, E, P1_F8_TILE0); } }
    }
    GSYNC();

    {   FRESH();
        for (int rep = 0; rep < NREP(2); ++rep) {
        phase_scan(a, lds, wave, lane);
        EpiQHead Eq{(bf16_t*)(ws + WS_QM), a.in[8], a.in[9], (const f32x2*)(ws + WS_ROPE), (unsigned char*)(ws + WS_QM8)};
        GEMM_DENSE((const bf16_t*)(ws + WS_CQN), 256, (const bf16_t*)(ws + WS_WUQ), NTOK, 2048, 256, Eq);
        EpiKVHead Ekv{(bf16_t*)(ws + WS_KVM), a.in[10], (unsigned char*)(ws + WS_K8)};
        GEMM_DENSE((const bf16_t*)(ws + WS_CKVN), 256, (const bf16_t*)(ws + WS_WUKV), NTOK, 2048, 256, Ekv);
        }
    }
    GSYNC();

    {   FRESH(); (void)ws;
        const bf16_t* Z = (const bf16_t*)(ws + WS_Z);
#if FAST_MLA
#if MFMA_BENCH
        mfma_bench<MFMA_BENCH>(ws, lane);
#endif
#if SHADOW_MLA
        attn_phase_fast<true, SHADOW_MLA>(a, lds);
#endif
        for (int rep = 0; rep < NREP(3); ++rep) attn_phase_fast<true>(a, lds);
#else
        attn_simple<192, 128, 128, 64, false>((const bf16_t*)(ws + WS_QM), 1536, (const bf16_t*)(ws + WS_KVM), 2048, (const bf16_t*)(ws + WS_KR), 64, (const bf16_t*)(ws + WS_KVM) + 128, 2048,
                                          (bf16_t*)(ws + WS_OM), 1024, nullptr, 8, 192, 256, 256, 128, gw, ngw, lane);
#endif
#if FAST_FOX
#if SHADOW_FOX
        attn_phase_fast<false, SHADOW_FOX>(a, lds, 2);
#endif
        for (int rep = 0; rep < NREP(4); ++rep) attn_phase_fast<false>(a, lds, rep);
#else
        attn_simple<64, 64, 64, 64, true>(Z + OFF_FQ, ZP, Z + OFF_FK, ZP, nullptr, 0, Z + OFF_FV, ZP, (bf16_t*)(ws + WS_OF), 1024, (const float*)(ws + WS_FC), 16, 64, 64, 64, 64, gw, ngw, lane);
#endif
    }
    GSYNC();
#if P4_CHAIN && !F8_P4 && !F8_P5
    {   FRESH(); EpiMixChain E{(const bf16_t*)(ws + WS_Z), (bf16_t*)(ws + WS_MIXED)};
        gemm_chain_fast(lds, ws + WS_OM, ws + WS_WOMLA, ws + WS_OF, ws + WS_WOFOX, NTOK, DM, DM, E); }
#else
    {   FRESH(); EpiMixA E{(bf16_t*)(ws + WS_MIXTMP), (const bf16_t*)(ws + WS_Z), F8_P4 ? 1.0f / (F8_SX * F8_SW) : 1.0f};
        for (int rep = 0; rep < NREP(5); ++rep) { if (F8_P4) GEMM_DENSE8(ws + WS_OM, ws + WS_WOMLA, NTOK, DM, DM, E); else GEMM_DENSE((const bf16_t*)(ws + WS_OM), DM, (const bf16_t*)(ws + WS_WOMLA), NTOK, DM, DM, E); } }
    {   FRESH(); EpiMixB E{(const bf16_t*)(ws + WS_MIXTMP), (const bf16_t*)(ws + WS_Z), (unsigned char*)(ws + WS_MIXED), F8_P4 ? 1.0f / (F8_SX * F8_SW) : 1.0f};
        for (int rep = 0; rep < NREP(9); ++rep) { if (F8_P4) GEMM_DENSE8(ws + WS_OF, ws + WS_WOFOX, NTOK, DM, DM, E); else GEMM_DENSE((const bf16_t*)(ws + WS_OF), DM, (const bf16_t*)(ws + WS_WOFOX), NTOK, DM, DM, E); } }
#endif
    GSYNC();
    {   FRESH(); EpiResid E{a.in[0], (bf16_t*)(ws + WS_X1B), F8_P5 ? 1.0f / (F8_SX * F8_SW) : 1.0f};
        for (int rep = 0; rep < NREP(6); ++rep) { if (F8_P5) GEMM_DENSE8(ws + WS_MIXED, ws + WS_WO, NTOK, DM, DM, E); else GEMM_DENSE((const bf16_t*)(ws + WS_MIXED), DM, (const bf16_t*)(ws + WS_WO), NTOK, DM, DM, E); } }
    GSYNC();
    { FRESH(); (void)ws; phase_router(a, lds, wave, lane); }
    GSYNC();
    {   FRESH(); EpiUpW E{(bf16_t*)(ws + WS_H), (const float*)(ws + WS_LISTR), a.in[22]};
        for (int rep = 0; rep < NREP(7); ++rep) MOE_GEMM(true, E); }
    GSYNC();
    {   FRESH(); EpiDownW E{(bf16_t*)(ws + WS_Y), (const float*)(ws + WS_LISTG), a.in[24]};
        for (int rep = 0; rep < NREP(8); ++rep) MOE_GEMM(false, E); }
    GSYNC();
    for (int rep = 0; rep < NREP(12); ++rep) { FRESH(); (void)ws; phase_combine(a, gw, ngw, lane); }
    GSYNC();
    {   FRESH(); EpiF32 E{(bf16_t*)(ws + WS_TMP)};
        for (int rep = 0; rep < NREP(10); ++rep) GEMM_DENSE((const bf16_t*)(ws + WS_PB), 256, (const bf16_t*)(ws + WS_WPP), NTOK, DM, 256, E); }
    {   FRESH(); EpiPle E{a.out, (const bf16_t*)(ws + WS_X2B), (const bf16_t*)(ws + WS_TMP), (const float*)(ws + WS_RSTD3)};
        for (int rep = 0; rep < NREP(11); ++rep) { if (F8_PLE) GEMM_DENSE8(ws + WS_X2F8, ws + WS_WPG, NTOK, DM, DM, E); else GEMM_DENSE((const bf16_t*)(ws + WS_X2B), DM, (const bf16_t*)(ws + WS_WPG), NTOK, DM, DM, E); } }
}

extern "C" void kernel_launch(void* const* d_in, const int* in_sizes, int n_in, void* d_out, int out_size, void* d_ws, size_t ws_size, hipStream_t stream) {
    static int grid = 0;
    if (grid == 0) {
        if (n_in != 28 || out_size != NTOK * DM || ws_size < WS_END) { fprintf(stderr, "kernel_launch: unexpected shapes (n_in %d out %d ws %zu)\n", n_in, out_size, ws_size); grid = -1; return; }
        int dev = 0, cus = 0, per_cu = 0;
        (void)hipGetDevice(&dev); (void)hipDeviceGetAttribute(&cus, hipDeviceAttributeMultiprocessorCount, dev);
        (void)hipFuncSetAttribute((const void*)fwd_megakernel, hipFuncAttributeMaxDynamicSharedMemorySize, LDS_BYTES);
        (void)hipOccupancyMaxActiveBlocksPerMultiprocessor(&per_cu, (const void*)fwd_megakernel, NTHREADS, LDS_BYTES);
        if (per_cu < 1) { fprintf(stderr, "kernel_launch: occupancy query says %d blocks per CU\n", per_cu); per_cu = 1; }
        grid = cus * per_cu;
    }
    if (grid < 0) return;
    (void)hipMemsetAsync((char*)d_ws + WS_CTL, 0, 65536, stream);
    Args a{};
    for (int i = 0; i < 28; ++i) a.in[i] = (const float*)d_in[i];
    a.out = (float*)d_out; a.ws = (unsigned char*)d_ws;
    void* kargs[] = {&a};
    hipError_t e = hipLaunchCooperativeKernel((const void*)fwd_megakernel, dim3(grid), dim3(NTHREADS), kargs, LDS_BYTES, stream);
    if (e != hipSuccess) fprintf(stderr, "cooperative launch failed: %s (grid %d)\n", hipGetErrorString(e), grid);
}
```

```cpp
#include <hip/hip_runtime.h>
#include <hip/hip_cooperative_groups.h>
#include <cstdio>
#include <cstdint>
namespace cg = cooperative_groups;
#ifndef ATT_F8
#define ATT_F8 1
#endif
#ifndef F8_P1
#define F8_P1 1
#endif
#ifndef P1_F8_TILE0
#define P1_F8_TILE0 0
#endif
#ifndef F8_P4
#define F8_P4 0
#endif
#ifndef F8_P5
#define F8_P5 0
#endif
#ifndef F8_PLE
#define F8_PLE 1
#endif
#ifndef WGM_WIDE
#define WGM_WIDE 4
#endif
#ifndef WGM_DENSE
#define WGM_DENSE 4
#endif
#ifndef WGM_UP
#define WGM_UP 4
#endif
#ifndef WGM_DOWN
#define WGM_DOWN 4
#endif
#ifndef FOX_PIPE
#define FOX_PIPE 1
#ifndef MLA_XCD1
#define MLA_XCD1 1
#endif
#ifndef KVBAL
#define KVBAL 1
#endif
#ifndef QPACK
#define QPACK 1
#endif
#ifndef PRO_PIPE
#define PRO_PIPE 1
#endif
#ifndef P4_CHAIN
#define P4_CHAIN 1
#endif
#ifndef FOX_KT256
#define FOX_KT256 1
#endif
#ifndef MLA_KT128
#define MLA_KT128 1
#endif
#ifndef FOX_BIAS_MFMA
#define FOX_BIAS_MFMA 1
#endif
#endif
#ifndef MLA_PIPE
#define MLA_PIPE 0
#endif

typedef unsigned short bf16_t;
typedef short bf16x8 __attribute__((ext_vector_type(8)));
typedef float f32x4 __attribute__((ext_vector_type(4)));
typedef float f32x2 __attribute__((ext_vector_type(2)));
typedef unsigned u32x4 __attribute__((ext_vector_type(4)));
typedef unsigned u32x2 __attribute__((ext_vector_type(2)));

constexpr int NTOK = 32768, SEQ = 8192, BATCH = 4, DM = 1024;
constexpr int OFF_CQ = 0, OFF_CKV = 256, OFF_KR = 512, OFF_FQ = 576, OFF_FK = 1600, OFF_FV = 2624, OFF_FL = 3648, OFF_GM = 3664, OFF_GF = 4688, IN_COLS = 5712;
constexpr int ZP = 5888;
constexpr int NEXP = 32, TOPK = 4, EFF = 1024;
constexpr int NTHREADS = 512, NWAVES = 8;
constexpr float EPS = 1e-6f;
constexpr float LOG2E = 1.4426950408889634f;
constexpr float C2_MLA = 0.07216878364870322f * LOG2E;
constexpr float C2_FOX = 0.125f * LOG2E;
constexpr int MAXTILES = 544;

constexpr size_t MiB = 1u << 20;
constexpr size_t WS_CTL = 0;
constexpr size_t WS_RSTD1 = 1 * MiB;
constexpr size_t WS_RSTD2 = WS_RSTD1 + 256 * 1024;
constexpr size_t WS_RSTD3 = WS_RSTD2 + 256 * 1024;
constexpr size_t WS_GATE = 2 * MiB;
constexpr size_t WS_LIST = 3 * MiB;
constexpr size_t WS_LISTR = 968 * MiB, WS_LISTG = 976 * MiB;
constexpr size_t WS_FL = 7 * MiB;
constexpr size_t WS_LF = 9 * MiB;
constexpr size_t WS_FC = 11 * MiB;
constexpr size_t WS_FCR = 32 * MiB;
constexpr size_t WS_ROPE = 13 * MiB;
constexpr size_t WS_WR3 = 15 * MiB;
constexpr size_t WS_KR8 = 7 * MiB;
constexpr size_t WS_FQ8 = 120 * MiB, WS_FK8 = 152 * MiB;
constexpr size_t WS_QM8 = 616 * MiB;
constexpr size_t WS_K8 = 664 * MiB;
constexpr size_t WS_PB = 16 * MiB;
constexpr size_t WS_WIN8 = 216 * MiB;
constexpr size_t WS_XF8 = 680 * MiB;
constexpr size_t WS_WIN = 32 * MiB;
constexpr size_t WS_WUQ = 44 * MiB;
constexpr size_t WS_WUKV = 45 * MiB;
constexpr size_t WS_WOMLA = 46 * MiB, WS_WOFOX = 48 * MiB, WS_WO = 50 * MiB, WS_WPG = 52 * MiB, WS_WPP = 54 * MiB;
constexpr size_t WS_WUP = 56 * MiB;
constexpr size_t WS_WDOWN = 184 * MiB;
constexpr size_t WS_Z = 248 * MiB;
constexpr size_t WS_H = 248 * MiB;
constexpr size_t WS_TMP = 320 * MiB;
constexpr size_t WS_QM = 616 * MiB;
constexpr size_t WS_XB = 616 * MiB;
constexpr size_t WS_MIXED = 776 * MiB;
constexpr size_t WS_X1B = 616 * MiB;
constexpr size_t WS_X2F8 = 384 * MiB;
constexpr size_t WS_X2B = 248 * MiB;
constexpr size_t WS_X1F8 = 684 * MiB;
constexpr size_t WS_KVM = 712 * MiB;
constexpr size_t WS_MIXTMP = 712 * MiB;
constexpr size_t WS_OM = 840 * MiB, WS_OF = 904 * MiB;
constexpr size_t WS_Y = 712 * MiB;
constexpr size_t WS_CQN = 968 * MiB, WS_CKVN = 984 * MiB;
constexpr size_t WS_KR = 1000 * MiB;
constexpr size_t WS_END = 1004 * MiB;
constexpr int LDS_BYTES = 150 * 1024;

__device__ __forceinline__ float bf2f(unsigned b) { return __uint_as_float(b << 16); }
__device__ __forceinline__ unsigned f2bf(float f) { unsigned u = __float_as_uint(f); return (u + 0x7fffu + ((u >> 16) & 1u)) >> 16; }
__device__ __forceinline__ unsigned pk2(float lo, float hi) { unsigned r; asm("v_cvt_pk_bf16_f32 %0, %1, %2" : "=v"(r) : "v"(lo), "v"(hi)); return r; }
__device__ __forceinline__ u32x2 pk4(f32x4 v) { u32x2 r; r.x = pk2(v[0], v[1]); r.y = pk2(v[2], v[3]); return r; }
__device__ __forceinline__ f32x4 unpk4(u32x2 w) { f32x4 r; r[0] = bf2f(w.x & 0xffffu); r[1] = bf2f(w.x >> 16); r[2] = bf2f(w.y & 0xffffu); r[3] = bf2f(w.y >> 16); return r; }
__device__ __forceinline__ float sigmoidf_(float x) { return __builtin_amdgcn_rcpf(1.0f + __builtin_amdgcn_exp2f(-LOG2E * x)); }
__device__ __forceinline__ float wave_sum(float v) {
#pragma unroll
    for (int o = 1; o < 64; o <<= 1) v += __shfl_xor(v, o);
    return v;
}
typedef int v8i __attribute__((ext_vector_type(8)));
typedef int v4i __attribute__((ext_vector_type(4)));
constexpr float F8_SW = 512.0f, F8_SX = 16.0f, F8_SH = 8.0f;
__device__ __forceinline__ unsigned pk4_fp8(f32x4 v) { int r = __builtin_amdgcn_cvt_pk_fp8_f32(v[0], v[1], 0, false); r = __builtin_amdgcn_cvt_pk_fp8_f32(v[2], v[3], r, true); return (unsigned)r; }
__device__ __forceinline__ unsigned pk4_fp8s(f32x4 v) {
    const float a = __builtin_amdgcn_fmed3f(v[0], -448.f, 448.f), b = __builtin_amdgcn_fmed3f(v[1], -448.f, 448.f), c = __builtin_amdgcn_fmed3f(v[2], -448.f, 448.f), d = __builtin_amdgcn_fmed3f(v[3], -448.f, 448.f);
    int r = __builtin_amdgcn_cvt_pk_fp8_f32(a, b, 0, false); r = __builtin_amdgcn_cvt_pk_fp8_f32(c, d, r, true); return (unsigned)r; }
__device__ __forceinline__ f32x4 mfma16f8(bf16x8 alo, bf16x8 ahi, bf16x8 blo, bf16x8 bhi, f32x4 c) {
    const v4i a0 = __builtin_bit_cast(v4i, alo), a1 = __builtin_bit_cast(v4i, ahi), b0 = __builtin_bit_cast(v4i, blo), b1 = __builtin_bit_cast(v4i, bhi);
    const v8i a = __builtin_shufflevector(a0, a1, 0, 1, 2, 3, 4, 5, 6, 7), b = __builtin_shufflevector(b0, b1, 0, 1, 2, 3, 4, 5, 6, 7);
    return __builtin_amdgcn_mfma_scale_f32_16x16x128_f8f6f4(a, b, c, 0, 0, 0, 0x7f7f7f7f, 0, 0x7f7f7f7f); }
__device__ __forceinline__ f32x4 mfma16(bf16x8 a, bf16x8 b, f32x4 c) { return __builtin_amdgcn_mfma_f32_16x16x32_bf16(a, b, c, 0, 0, 0); }

struct Args { const float* in[28]; float* out; unsigned char* ws; };
__device__ __forceinline__ void rope_cs(int pos, int i, float& c, float& s) {
    const float inv = exp2f(-(float)(2 * i) * (13.287712379549449f / 64.0f));
    const float ang = (float)pos * inv;
    const double rev = (double)ang * 0.15915494309189535; const double fr = rev - rint(rev);
    const float f = (float)fr; c = __builtin_amdgcn_cosf(f); s = __builtin_amdgcn_sinf(f);
}


template <int MODE  >
__device__ __forceinline__ void transpose_item(const float* W, int ldw, int nvalid, int K, bf16_t* Wt, const float* gain, float* scr, int kb, int nb, int lane) {
    const int k0 = 64 * kb, n0 = 32 * nb, c4 = lane & 7, rr = lane >> 3;
    f32x4 v[8];
#pragma unroll
    for (int i = 0; i < 8; ++i) {
        const int kk = rr + 8 * i, n = n0 + 4 * c4;
        v[i] = (n < nvalid) ? __builtin_nontemporal_load((const f32x4*)(W + (size_t)(k0 + kk) * ldw + n)) : (f32x4){0.f, 0.f, 0.f, 0.f};
        if (gain) v[i] = v[i] * gain[k0 + kk];
    }
#pragma unroll
    for (int i = 0; i < 8; ++i) { float* d = scr + (rr + 8 * i) * 33 + 4 * c4; d[0] = v[i][0]; d[1] = v[i][1]; d[2] = v[i][2]; d[3] = v[i][3]; }
    asm volatile("s_waitcnt lgkmcnt(0)" ::: "memory");
    const int c = lane & 7;
#pragma unroll
    for (int j = 0; j < 4; ++j) {
        const int n = (lane >> 3) + 8 * j; const float* s = scr + (8 * c) * 33 + n;
        u32x4 o; o.x = pk2(s[0 * 33], s[1 * 33]); o.y = pk2(s[2 * 33], s[3 * 33]); o.z = pk2(s[4 * 33], s[5 * 33]); o.w = pk2(s[6 * 33], s[7 * 33]);
        int L = n0 + n, drow = (L & ~31) + 16 * ((L >> 2) & 1) + 4 * ((L >> 3) & 3) + (L & 3);
        if (MODE == 1) { const int half = L >> 10, cc = L & 1023, w32 = cc & 31;
            drow = 256 * (cc >> 7) + 128 * half + 32 * ((cc & 127) >> 5) + 16 * ((w32 >> 2) & 1) + 4 * ((w32 >> 3) & 3) + (w32 & 3); }
        if (MODE == 2 || MODE == 3 || MODE == 4) {
            int Lp = L;
            if (MODE == 2) Lp = (L / 192) * 256 + (L % 192);
            if (MODE == 4) { const int h = L / 192, c = L % 192; Lp = (c < 128) ? ((h >> 1) * 256 + (h & 1) * 128 + c) : ((4 + (h >> 2)) * 256 + (h & 3) * 64 + (c - 128)); }
            const int T = Lp >> 8, lb = (Lp & 255) >> 5, w = Lp & 31;
            drow = 256 * T + 32 * (4 * (lb & 1) + (lb >> 1)) + 16 * ((w >> 2) & 1) + 4 * ((w >> 3) & 3) + (w & 3); }
        *(u32x4*)(Wt + (size_t)drow * K + k0 + 8 * c) = o;
    }
    asm volatile("s_waitcnt lgkmcnt(0)" ::: "memory");
}


template <int MODE>
__device__ __forceinline__ void transpose_item8(const float* W, int ldw, int K, unsigned char* Wt, const float* gain, float* scr, int kb, int nb, int lane) {
    const int k0 = 64 * kb, n0 = 32 * nb, c4 = lane & 7, rr = lane >> 3;
    f32x4 v[8];
#pragma unroll
    for (int i = 0; i < 8; ++i) { const int kk = rr + 8 * i; v[i] = (n0 + 4 * c4 < ldw) ? __builtin_nontemporal_load((const f32x4*)(W + (size_t)(k0 + kk) * ldw + n0 + 4 * c4)) : (f32x4){0.f, 0.f, 0.f, 0.f}; v[i] = v[i] * ((gain ? gain[k0 + kk] : 1.0f) * F8_SW); }
#pragma unroll
    for (int i = 0; i < 8; ++i) { float* d = scr + (rr + 8 * i) * 33 + 4 * c4; d[0] = v[i][0]; d[1] = v[i][1]; d[2] = v[i][2]; d[3] = v[i][3]; }
    asm volatile("s_waitcnt lgkmcnt(0)" ::: "memory");
    const int n = lane >> 1, kh = 32 * (lane & 1); const float* sp = scr + kh * 33 + n; unsigned w[8];
#pragma unroll
    for (int q = 0; q < 8; ++q) w[q] = pk4_fp8s((f32x4){sp[(4 * q) * 33], sp[(4 * q + 1) * 33], sp[(4 * q + 2) * 33], sp[(4 * q + 3) * 33]});
    const int L = n0 + n; int drow = (L & ~31) + 16 * ((L >> 2) & 1) + 4 * ((L >> 3) & 3) + (L & 3);
    if (MODE == 1) { const int half = L >> 10, cc = L & 1023, w32 = cc & 31; drow = 256 * (cc >> 7) + 128 * half + 32 * ((cc & 127) >> 5) + 16 * ((w32 >> 2) & 1) + 4 * ((w32 >> 3) & 3) + (w32 & 3); }
    if (MODE == 3) { const int T = L >> 8, lb = (L & 255) >> 5, w = L & 31; drow = 256 * T + 32 * (4 * (lb & 1) + (lb >> 1)) + 16 * ((w >> 2) & 1) + 4 * ((w >> 3) & 3) + (w & 3); }
    unsigned char* dp = Wt + (size_t)drow * K + k0 + kh;
    *(u32x4*)dp = (u32x4){w[0], w[1], w[2], w[3]}; *(u32x4*)(dp + 16) = (u32x4){w[4], w[5], w[6], w[7]};
    asm volatile("s_waitcnt lgkmcnt(0)" ::: "memory");
}

__device__ __forceinline__ void t8_load(const float* W, int ldw, const float* gain, int kb, int nb, int lane, f32x4 (&v)[8], float (&g)[8]) {
    const int k0 = 64 * kb, n0 = 32 * nb, c4 = lane & 7, rr = lane >> 3;
#pragma unroll
    for (int i = 0; i < 8; ++i) { const int kk = rr + 8 * i; v[i] = __builtin_nontemporal_load((const f32x4*)(W + (size_t)(k0 + kk) * ldw + n0 + 4 * c4)); g[i] = gain ? gain[k0 + kk] : 1.0f; }
}
template <int MODE>
__device__ __forceinline__ void t8_finish(int K, unsigned char* Wt, float* scr, int kb, int nb, int lane, const f32x4 (&v)[8], const float (&g)[8]) {
    const int k0 = 64 * kb, n0 = 32 * nb, c4 = lane & 7, rr = lane >> 3;
#pragma unroll
    for (int i = 0; i < 8; ++i) { const f32x4 x = v[i] * (g[i] * F8_SW); float* d = scr + (rr + 8 * i) * 33 + 4 * c4; d[0] = x[0]; d[1] = x[1]; d[2] = x[2]; d[3] = x[3]; }
    asm volatile("s_waitcnt lgkmcnt(0)" ::: "memory");
    const int n = lane >> 1, kh = 32 * (lane & 1); const float* sp = scr + kh * 33 + n; unsigned w[8];
#pragma unroll
    for (int q = 0; q < 8; ++q) w[q] = pk4_fp8s((f32x4){sp[(4 * q) * 33], sp[(4 * q + 1) * 33], sp[(4 * q + 2) * 33], sp[(4 * q + 3) * 33]});
    const int L = n0 + n; int drow = (L & ~31) + 16 * ((L >> 2) & 1) + 4 * ((L >> 3) & 3) + (L & 3);
    if (MODE == 1) { const int half = L >> 10, cc = L & 1023, w32 = cc & 31; drow = 256 * (cc >> 7) + 128 * half + 32 * ((cc & 127) >> 5) + 16 * ((w32 >> 2) & 1) + 4 * ((w32 >> 3) & 3) + (w32 & 3); }
    unsigned char* dp = Wt + (size_t)drow * K + k0 + kh;
    *(u32x4*)dp = (u32x4){w[0], w[1], w[2], w[3]}; *(u32x4*)(dp + 16) = (u32x4){w[4], w[5], w[6], w[7]};
    asm volatile("s_waitcnt lgkmcnt(0)" ::: "memory");
}

__device__ __forceinline__ void phase_prologue(const Args& a, char* lds, int gw, int ngw, int wave, int lane) {
    float* scr = (float*)(lds + wave * 16384);
    unsigned char* ws = a.ws;
    constexpr int I_WIN = 16 * 179, I_WUQ = 4 * 48, I_WUKV = 4 * 64, I_SQ = 16 * 32, I_WPP = 4 * 32, I_UP = 16 * 64, I_DN = 16 * 32;
    constexpr int NITEMS = I_WIN + I_WUQ + I_WUKV + 4 * I_SQ + I_WPP + (PRO_PIPE ? 0 : NEXP * I_UP + NEXP * I_DN);
    for (int it = gw; it < NITEMS; it += ngw) {
        int r = it;
        if (r < I_WIN) { if (F8_P1 && ((r % 179) * 32) / 256 >= P1_F8_TILE0) transpose_item8<3>(a.in[3], IN_COLS, 1024, (unsigned char*)(ws + WS_WIN8), a.in[2], scr, r / 179, r % 179, lane); else transpose_item<3>(a.in[3], IN_COLS, IN_COLS, 1024, (bf16_t*)(ws + WS_WIN), a.in[2], scr, r / 179, r % 179, lane); continue; } r -= I_WIN;
        if (r < I_WUQ) { transpose_item<QPACK ? 4 : 2>(a.in[5], 1536, 1536, 256, (bf16_t*)(ws + WS_WUQ), a.in[4], scr, r / 48, r % 48, lane); continue; } r -= I_WUQ;
        if (r < I_WUKV) { transpose_item<(KVBAL && ATT_F8) ? 0 : 3>(a.in[7], 2048, 2048, 256, (bf16_t*)(ws + WS_WUKV), a.in[6], scr, r / 64, r % 64, lane); continue; } r -= I_WUKV;
        if (r < I_SQ) { if (F8_P4) transpose_item8<0>(a.in[15], 1024, 1024, (unsigned char*)(ws + WS_WOMLA), nullptr, scr, r / 32, r % 32, lane); else transpose_item<0>(a.in[15], 1024, 1024, 1024, (bf16_t*)(ws + WS_WOMLA), nullptr, scr, r / 32, r % 32, lane); continue; } r -= I_SQ;
        if (r < I_SQ) { if (F8_P4) transpose_item8<0>(a.in[16], 1024, 1024, (unsigned char*)(ws + WS_WOFOX), nullptr, scr, r / 32, r % 32, lane); else transpose_item<0>(a.in[16], 1024, 1024, 1024, (bf16_t*)(ws + WS_WOFOX), nullptr, scr, r / 32, r % 32, lane); continue; } r -= I_SQ;
        if (r < I_SQ) { if (F8_P5) transpose_item8<0>(a.in[17], 1024, 1024, (unsigned char*)(ws + WS_WO), nullptr, scr, r / 32, r % 32, lane); else transpose_item<0>(a.in[17], 1024, 1024, 1024, (bf16_t*)(ws + WS_WO), nullptr, scr, r / 32, r % 32, lane); continue; } r -= I_SQ;
        if (r < I_SQ) { if (F8_PLE) transpose_item8<0>(a.in[26], 1024, 1024, (unsigned char*)(ws + WS_WPG), a.in[25], scr, r / 32, r % 32, lane); else transpose_item<0>(a.in[26], 1024, 1024, 1024, (bf16_t*)(ws + WS_WPG), a.in[25], scr, r / 32, r % 32, lane); continue; } r -= I_SQ;
        if (r < I_WPP) { transpose_item<0>(a.in[27], 1024, 1024, 256, (bf16_t*)(ws + WS_WPP), nullptr, scr, r / 32, r % 32, lane); continue; } r -= I_WPP;
        if (PRO_PIPE) continue;
        if (r < NEXP * I_UP) { const int e = r / I_UP, q = r % I_UP;
            transpose_item8<1>(a.in[21] + (size_t)e * 1024 * 2048, 2048, 1024, (unsigned char*)(ws + WS_WUP) + (size_t)e * 2048 * 1024, a.in[18], scr, q / 64, q % 64, lane); continue; } r -= NEXP * I_UP;
        { const int e = r / I_DN, q = r % I_DN;
            transpose_item8<0>(a.in[23] + (size_t)e * 1024 * 1024, 1024, 1024, (unsigned char*)(ws + WS_WDOWN) + (size_t)e * 1024 * 1024, nullptr, scr, q / 32, q % 32, lane); }
    }
#if PRO_PIPE
    {
        f32x4 v0[8], v1[8]; float g0[8], g1[8];
        {   const float* Wb = a.in[21]; unsigned char* Tb = (unsigned char*)(ws + WS_WUP); const float* gn = a.in[18]; constexpr int HP = I_UP / 2, TOT = NEXP * HP;
            for (int it = gw; it < TOT; it += ngw) { const int e = it / HP, q = it % HP, kb = 2 * (q / 64), nb = q % 64; const float* W = Wb + (size_t)e * 1024 * 2048; unsigned char* T = Tb + (size_t)e * 2048 * 1024;
                t8_load(W, 2048, gn, kb, nb, lane, v0, g0); t8_load(W, 2048, gn, kb + 1, nb, lane, v1, g1);
                t8_finish<1>(1024, T, scr, kb, nb, lane, v0, g0); t8_finish<1>(1024, T, scr, kb + 1, nb, lane, v1, g1); } }
        {   const float* Wb = a.in[23]; unsigned char* Tb = (unsigned char*)(ws + WS_WDOWN); constexpr int HP = I_DN / 2, TOT = NEXP * HP;
            for (int it = gw; it < TOT; it += ngw) { const int e = it / HP, q = it % HP, kb = 2 * (q / 32), nb = q % 32; const float* W = Wb + (size_t)e * 1024 * 1024; unsigned char* T = Tb + (size_t)e * 1024 * 1024;
                t8_load(W, 1024, nullptr, kb, nb, lane, v0, g0); t8_load(W, 1024, nullptr, kb + 1, nb, lane, v1, g1);
                t8_finish<0>(1024, T, scr, kb, nb, lane, v0, g0); t8_finish<0>(1024, T, scr, kb + 1, nb, lane, v1, g1); } }
    }
#endif
    const float* x = a.in[0]; bf16_t* XB = (bf16_t*)(ws + WS_XB); float* RSTD1 = (float*)(ws + WS_RSTD1);
    for (int m0 = gw; m0 < NTOK; m0 += 4 * ngw) {
        f32x4 vv[4][4];
#pragma unroll
        for (int u = 0; u < 4; ++u) { const int mu = m0 + u * ngw; if (mu < NTOK) { const f32x4* xr = (const f32x4*)(x + (size_t)mu * DM) + lane;
#pragma unroll
            for (int j = 0; j < 4; ++j) vv[u][j] = __builtin_nontemporal_load(xr + 64 * j); } }
#pragma unroll
      for (int u = 0; u < 4; ++u) { const int m = m0 + u * ngw; if (m >= NTOK) break;
        f32x4 v[4]; float s = 0.f;
#pragma unroll
        for (int j = 0; j < 4; ++j) { v[j] = vv[u][j]; s += (v[j][0] * v[j][0] + v[j][1] * v[j][1]) + (v[j][2] * v[j][2] + v[j][3] * v[j][3]); }
        s = wave_sum(s);
        if (lane == 0) RSTD1[m] = __builtin_amdgcn_rsqf(s * (1.0f / DM) + EPS);
        if (F8_P1) { unsigned* o8 = (unsigned*)(ws + WS_XF8 + (size_t)m * DM) + lane;
#pragma unroll
            for (int j = 0; j < 4; ++j) o8[64 * j] = pk4_fp8s(v[j] * F8_SX); }
        if (!F8_P1 || P1_F8_TILE0 > 0) { u32x2* o = (u32x2*)(XB + (size_t)m * DM) + lane;
#pragma unroll
        for (int j = 0; j < 4; ++j) o[64 * j] = pk4(v[j]); }
      }
    }
    { f32x2* RT = (f32x2*)(ws + WS_ROPE);
      for (int idx = gw * 64 + lane; idx < SEQ * 32; idx += ngw * 64) { float c, sn; rope_cs(idx >> 5, idx & 31, c, sn); RT[idx] = (f32x2){c, sn}; } }
    { bf16_t* WR3 = (bf16_t*)(ws + WS_WR3); const float* wr = a.in[19]; const float* gf = a.in[18];
      for (int idx = gw * 64 + lane; idx < 1024 * 32; idx += ngw * 64) { const int k = idx >> 5, e = idx & 31; const float w = wr[idx] * gf[k];
          const unsigned h = f2bf(w); const float r1 = w - bf2f(h); const unsigned m = f2bf(r1); const float r2 = r1 - bf2f(m); const unsigned l = f2bf(r2);
          WR3[e * 1024 + k] = (bf16_t)h; WR3[32768 + e * 1024 + k] = (bf16_t)m; WR3[65536 + e * 1024 + k] = (bf16_t)l; } }
    const float* p = a.in[1]; bf16_t* PB = (bf16_t*)(ws + WS_PB);
    for (int m = gw; m < NTOK; m += 4 * ngw) {
        f32x4 v[4];
#pragma unroll
        for (int u = 0; u < 4; ++u) { const int mm = m + u * ngw; if (mm < NTOK) v[u] = __builtin_nontemporal_load((const f32x4*)(p + (size_t)mm * 256) + lane); }
#pragma unroll
        for (int u = 0; u < 4; ++u) { const int mm = m + u * ngw; if (mm < NTOK) *((u32x2*)(PB + (size_t)mm * 256) + lane) = pk4(v[u]); } }
}

struct UnitCtx { int row0; int e; int idx0; int cnt; const int* list; int par; };
template <class RowPtr, class Epi>
__device__ __forceinline__ void gemm_unit_simple(const RowPtr& RP, const bf16_t* Bt, int ldb, int K, int colbase, const UnitCtx& uc, const Epi& E, int wave, int lane) {
    const int fr = lane & 15, fq = lane >> 4;
    const bf16_t* a0 = RP(32 * wave + fr) + 8 * fq; const bf16_t* a1 = RP(32 * wave + 16 + fr) + 8 * fq;
    for (int cgp = 0; cgp < 4; ++cgp) {
        f32x4 acc[2][4];
#pragma unroll
        for (int i = 0; i < 2; ++i)
#pragma unroll
            for (int n = 0; n < 4; ++n) acc[i][n] = (f32x4){0.f, 0.f, 0.f, 0.f};
        const bf16_t* b = Bt + (size_t)(64 * cgp + fr) * ldb + 8 * fq;
        for (int k0 = 0; k0 < K; k0 += 32) {
            const bf16x8 av0 = *(const bf16x8*)(a0 + k0), av1 = *(const bf16x8*)(a1 + k0);
#pragma unroll
            for (int n = 0; n < 4; ++n) { const bf16x8 bv = *(const bf16x8*)(b + (size_t)16 * n * ldb + k0);
                acc[0][n] = mfma16(bv, av0, acc[0][n]); acc[1][n] = mfma16(bv, av1, acc[1][n]); }
        }
#pragma unroll
        for (int mi = 0; mi < 2; ++mi)
#pragma unroll
            for (int pp = 0; pp < 2; ++pp) E(uc, 32 * wave + 16 * mi + fr, colbase + 64 * cgp + 32 * pp, fq, acc[mi][2 * pp], acc[mi][2 * pp + 1], E.row_pre(uc, 32 * wave + 16 * mi + fr));
    }
}
struct DenseRows { const bf16_t* A; int lda; __device__ __forceinline__ const bf16_t* operator()(int r) const { return A + (size_t)r * lda; } };
template <class Epi>
__device__ __forceinline__ void gemm_dense(const bf16_t* A, int lda, const bf16_t* Bt, int M, int N, int K, const Epi& E, int wave, int lane) {
    const int nN = N / 256, nU = (M / 256) * nN;
    for (int u = blockIdx.x; u < nU; u += gridDim.x) {
        const int pm = u / nN, pn = u % nN;
        UnitCtx uc; uc.row0 = pm * 256; uc.e = 0; uc.idx0 = 0; uc.cnt = 0; uc.list = nullptr;
        DenseRows RP{A + (size_t)pm * 256 * lda, lda};
        gemm_unit_simple(RP, Bt + (size_t)pn * 256 * K, K, K, pn * 256, uc, E, wave, lane);
    }
}


#define LAS __attribute__((address_space(3)))
namespace pg8 {
constexpr int BM = 256, BK = 64, HALF = 128, HTB = HALF * BK * 2, STAGE_BYTES = 8 * HTB, NXCD = 8;
__device__ __forceinline__ int lds_byte(int r, int c) { const int st = (r >> 4) * 2 + (c >> 5), rr = r & 15, cc = c & 31, ob = rr * 64 + cc * 2; return st * 1024 + (ob ^ (((ob >> 9) & 1) << 5)); }
__device__ __forceinline__ void stage_rc(int b, int& R, int& C) { const int st = b / 1024, sb = b % 1024, swz = sb ^ (((sb >> 9) & 1) << 5); R = (st >> 1) * 16 + swz / 64; C = (st & 1) * 32 + (swz % 64) / 2; }
struct Unit { int pm, pn; };
struct StaticOrder {
    int nM, nN, nwg, G, c, WGM;
    __device__ void init(int nM_, int nN_, int G_, int c_, int wgm_ = 4) { nM = nM_; nN = nN_; nwg = nM * nN; G = G_; c = c_; WGM = wgm_; }
    __device__ bool next(int i, Unit& u) const {
        const long L = (long)i * G + c; if (L >= nwg) return false;
        int wgid = (int)L; { const int q = nwg / NXCD, r = nwg % NXCD, xcd = wgid % NXCD, off = wgid / NXCD; wgid = (xcd < r ? xcd * (q + 1) : r * (q + 1) + (xcd - r) * q) + off; }
        const int nig = WGM * nN, gid = wgid / nig, fm = gid * WGM, gsz = (nM - fm) < WGM ? (nM - fm) : WGM;
        u.pm = fm + ((wgid % nig) % gsz); u.pn = (wgid % nig) / gsz; return true;
    }
};
struct GUnit { const char* A; const char* B; UnitCtx uc; int colbase; };
template <class T, class = void> struct has_pf { static constexpr bool value = false; };
template <class T> struct has_pf<T, decltype((void)T::PF)> { static constexpr bool value = true; };
template <class T, class = void> struct has_chain { static constexpr bool value = false; };
template <class T> struct has_chain<T, decltype((void)T::CHAIN)> { static constexpr bool value = true; };
template <class T, class = void> struct has_pre { static constexpr bool value = false; };
template <class T> struct has_pre<T, decltype((void)T::PD)> { static constexpr bool value = true; };
template <class T, class = void> struct is_whole { static constexpr bool value = false; };
template <class T> struct is_whole<T, decltype((void)T::WHOLE)> { static constexpr bool value = true; };

template <class Epi, class Sched, bool GATHER, bool F8 = false>
__device__ __forceinline__ void gemm_phase(LAS unsigned char* lds, const int K_in, const Sched& S, const Epi& E) {
    int K = K_in; asm volatile("" : "+s"(K));
    int tid = threadIdx.x; asm volatile("" : "+v"(tid));
    const int wid = __builtin_amdgcn_readfirstlane(tid >> 6), lane = tid & 63, wr = wid >> 2, wc = wid & 3, fr = lane & 15, fq = lane >> 4;
    const int RB = F8 ? K : 2 * K;
    const int nt = RB / 128;
    int Rr[2], Cc[2]; unsigned voffA[2];
#pragma unroll
    for (int i = 0; i < 2; ++i) { stage_rc(tid * 16 + i * 8192, Rr[i], Cc[i]); voffA[i] = (unsigned)(Rr[i] * RB + Cc[i] * 2); }
    const size_t kstep = (size_t)(BK * 2);
    const size_t hstep = (size_t)HALF * RB;
    const unsigned ldsw = (unsigned)wid * 1024u;
    const int aoff = lds_byte(wr * 64 + fr, fq * 8), boff = lds_byte(wc * 32 + fr, fq * 8);
#define PG8_SA(b, h) (((b) * 2 + (h)) * HTB)
#define PG8_SB(b, h) ((4 + (b) * 2 + (h)) * HTB)
#define PG8_RAW(bufoff, g0, g1) do { __builtin_amdgcn_global_load_lds((const unsigned*)(g0), (LAS unsigned*)(lds + (bufoff) + ldsw), 16, 0, 0); \
        __builtin_amdgcn_global_load_lds((const unsigned*)(g1), (LAS unsigned*)(lds + (bufoff) + ldsw + 8192), 16, 0, 0); } while (0)
#define PG8_STB(bufoff, bp) do { const char* p_ = (bp); PG8_RAW(bufoff, p_ + voffA[0], p_ + voffA[1]); } while (0)
#define PG8_STA(bufoff, SEL, H, KOFF) do { if constexpr (GATHER) { const unsigned o0_ = (SEL) ? offn[H][0] : offc[H][0], o1_ = (SEL) ? offn[H][1] : offc[H][1]; const char* p_ = cA + (KOFF); PG8_RAW(bufoff, p_ + o0_, p_ + o1_); } \
        else { const char* p_ = ((SEL) ? nA : cA) + (size_t)(H) * hstep + (KOFF); PG8_RAW(bufoff, p_ + voffA[0], p_ + voffA[1]); } } while (0)
#define PG8_CAT(lo, hi) __builtin_shufflevector(__builtin_bit_cast(v4i, lo), __builtin_bit_cast(v4i, hi), 0, 1, 2, 3, 4, 5, 6, 7)
#define PG8_LDA(dst, b, h) do { if constexpr (F8) { _Pragma("unroll") for (int m = 0; m < 4; ++m) dst##8[m] = PG8_CAT(*(const LAS bf16x8*)(lds + PG8_SA(b, h) + aoff + m * 2048), *(const LAS bf16x8*)(lds + PG8_SA(b, h) + aoff + m * 2048 + 1024)); } \
        else { _Pragma("unroll") for (int m = 0; m < 4; ++m) _Pragma("unroll") for (int k = 0; k < 2; ++k) dst[m][k] = *(const LAS bf16x8*)(lds + PG8_SA(b, h) + aoff + m * 2048 + k * 1024); } } while (0)
#define PG8_LDB(dst, b, h) do { if constexpr (F8) { _Pragma("unroll") for (int n = 0; n < 2; ++n) dst##8[n] = PG8_CAT(*(const LAS bf16x8*)(lds + PG8_SB(b, h) + boff + n * 2048), *(const LAS bf16x8*)(lds + PG8_SB(b, h) + boff + n * 2048 + 1024)); } \
        else { _Pragma("unroll") for (int n = 0; n < 2; ++n) _Pragma("unroll") for (int k = 0; k < 2; ++k) dst[n][k] = *(const LAS bf16x8*)(lds + PG8_SB(b, h) + boff + n * 2048 + k * 1024); } } while (0)
#define PG8_MMA(ai, bj, At, Bt) do { __builtin_amdgcn_s_setprio(1); \
        if constexpr (F8) { _Pragma("unroll") for (int m = 0; m < 4; ++m) _Pragma("unroll") for (int n = 0; n < 2; ++n) \
            asm volatile("v_mfma_scale_f32_16x16x128_f8f6f4 %0, %1, %2, %0, %3, %3 op_sel_hi:[0,0,0]" : "+v"(acc[ai][bj][m][n]) : "v"(Bt##8[n]), "v"(At##8[m]), "v"(f8scale)); } \
        else { _Pragma("unroll") for (int m = 0; m < 4; ++m) _Pragma("unroll") for (int n = 0; n < 2; ++n) _Pragma("unroll") for (int k = 0; k < 2; ++k) \
            acc[ai][bj][m][n] = __builtin_amdgcn_mfma_f32_16x16x32_bf16(Bt[n][k], At[m][k], acc[ai][bj][m][n], 0, 0, 0); } \
        __builtin_amdgcn_s_setprio(0); } while (0)
#define PG8_WAIT_V(n) asm volatile("s_waitcnt vmcnt(" #n ")" ::: "memory")
#define PG8_WAIT_L(n) asm volatile("s_waitcnt lgkmcnt(" #n ")" ::: "memory")
#define PG8_BAR __builtin_amdgcn_s_barrier()
#define PG8_SCHED __builtin_amdgcn_sched_barrier(0)
    GUnit cur, nxt; int ui = 0;
    if (!S.next(0, cur)) return;
    unsigned offc[2][2], offn[2][2];
    if constexpr (GATHER) S.gather_offsets(cur, Rr, Cc, offc, RB);
    f32x4 acc[2][2][4][2];
#pragma unroll
    for (int a = 0; a < 2; ++a)
#pragma unroll
        for (int b = 0; b < 2; ++b)
#pragma unroll
            for (int m = 0; m < 4; ++m)
#pragma unroll
                for (int n = 0; n < 2; ++n) acc[a][b][m][n] = (f32x4){0.f, 0.f, 0.f, 0.f};
    bf16x8 At[4][2], B0[2][2], B1[2][2];
    v8i At8[4], B08[2], B18[2];
    const int f8scale = 0x7f7f7f7f;
    const char* cA = cur.A; const char* cB = cur.B;
    const char* nA = cA;
    PG8_STB(PG8_SB(0, 0), cB); PG8_STB(PG8_SB(0, 1), cB + hstep); PG8_STA(PG8_SA(0, 0), false, 0, 0); PG8_STA(PG8_SA(0, 1), false, 1, 0);
    if (wr == 1) PG8_BAR;
    PG8_WAIT_V(2); PG8_BAR;
    PG8_STB(PG8_SB(1, 0), cB + kstep); PG8_STA(PG8_SA(1, 0), false, 0, kstep); PG8_STB(PG8_SB(1, 1), cB + hstep + kstep);
    PG8_WAIT_V(6); PG8_BAR;
    cur.uc.par = 0;
    if constexpr (has_pf<Epi>::value) E.prefetch(cur.uc, cur.colbase, (unsigned char*)lds + 131072 + 12288, wid, lane);
    for (;;) {
        const bool has_next = S.next(ui + 1, nxt);
        cur.uc.par = ui & 1;
        if constexpr (GATHER) {
            if (has_next) { if (ui == 0) S.gather_offsets(nxt, Rr, Cc, offn, RB); else S.gather_from_lds(nxt, (const int*)((unsigned char*)lds + 131072 + 18432 + ((ui + 1) & 1) * 1024), Rr, Cc, offn, RB); }
            else {
#pragma unroll
            for (int h = 0; h < 2; ++h) { offn[h][0] = offc[h][0]; offn[h][1] = offc[h][1]; } }
            GUnit n2; if (S.next(ui + 2, n2)) { if (wid == 0) S.gather_prefetch(n2, (unsigned char*)lds + 131072 + 18432 + (ui & 1) * 1024, lane); } }
        nA = has_next ? nxt.A : cA; const char* nB = has_next ? nxt.B : cB;
        for (int t = 0; t < nt; t += 2) {
            const bool last = (t == nt - 2);
            const size_t k1 = (size_t)(t + 1) * kstep;
            const size_t k2 = last ? 0 : (size_t)(t + 2) * kstep, k3 = k2 + kstep;
            const char* b2 = (last ? nB : cB) + k2; const char* b3 = b2 + kstep;
            PG8_LDB(B0, 0, 0); PG8_LDB(B1, 0, 1); PG8_SCHED; PG8_LDA(At, 0, 0); PG8_STA(PG8_SA(1, 1), false, 1, k1);
            PG8_WAIT_V(8); PG8_WAIT_L(0); PG8_BAR; PG8_MMA(0, 0, At, B0); PG8_MMA(0, 1, At, B1); PG8_BAR; PG8_SCHED;
            PG8_LDA(At, 0, 1); PG8_STB(PG8_SB(0, 0), b2); PG8_STB(PG8_SB(0, 1), b2 + hstep); PG8_STA(PG8_SA(0, 0), last, 0, k2);
            PG8_WAIT_V(8); PG8_WAIT_L(0); PG8_BAR; PG8_MMA(1, 0, At, B0); PG8_MMA(1, 1, At, B1); PG8_BAR; PG8_SCHED;
            PG8_LDB(B0, 1, 0); PG8_LDB(B1, 1, 1); PG8_SCHED; PG8_LDA(At, 1, 0); PG8_STA(PG8_SA(0, 1), last, 1, k2);
            PG8_WAIT_V(8); PG8_WAIT_L(0); PG8_BAR; PG8_MMA(0, 0, At, B0); PG8_MMA(0, 1, At, B1); PG8_BAR; PG8_SCHED;
            PG8_LDA(At, 1, 1); PG8_STB(PG8_SB(1, 0), b3); PG8_STB(PG8_SB(1, 1), b3 + hstep); PG8_STA(PG8_SA(1, 0), last, 0, k3);
            PG8_WAIT_V(8); PG8_WAIT_L(0); PG8_BAR; PG8_MMA(1, 0, At, B0); PG8_MMA(1, 1, At, B1); PG8_BAR; PG8_SCHED;
        }
        if constexpr (F8) asm volatile("s_nop 15\n\ts_nop 7" ::: "memory");
        if (wr == 0) PG8_BAR;
        if constexpr (is_whole<Epi>::value) { E.whole(acc, cur.uc, cur.colbase, wr, wc, fr, fq, (float*)((unsigned char*)lds + 131072 + 8192)); }
        else {
        typename Epi::RowT rowv[2][4];
#pragma unroll
        for (int ai = 0; ai < 2; ++ai)
#pragma unroll
            for (int m = 0; m < 4; ++m) rowv[ai][m] = E.row_pre(cur.uc, ai * HALF + wr * 64 + m * 16 + fr);
        if constexpr (has_pre<Epi>::value) {
            constexpr int PD = Epi::PD;
            typename Epi::PreT pre[PD];
#define PG8_IR(i) ((((i) >> 3) & 1) * HALF + wr * 64 + (((i) >> 1) & 3) * 16 + fr)
#define PG8_IC(i) (cur.colbase + ((i) & 1) * HALF + wc * 32)
#pragma unroll
            for (int i = 0; i < PD; ++i) pre[i] = E.pre(cur.uc, PG8_IR(i), PG8_IC(i), fq);
            __builtin_amdgcn_sched_barrier(0);
#pragma unroll
            for (int i = 0; i < 16; ++i) {
                E.post(cur.uc, PG8_IR(i), PG8_IC(i), fq, acc[(i >> 3) & 1][i & 1][(i >> 1) & 3][0], acc[(i >> 3) & 1][i & 1][(i >> 1) & 3][1], rowv[(i >> 3) & 1][(i >> 1) & 3], pre[i % PD]);
                if (i + PD < 16) pre[i % PD] = E.pre(cur.uc, PG8_IR(i + PD), PG8_IC(i + PD), fq);
                __builtin_amdgcn_sched_barrier(0);
            }
#undef PG8_IR
#undef PG8_IC
        } else {
#pragma unroll
        for (int ai = 0; ai < 2; ++ai)
#pragma unroll
            for (int m = 0; m < 4; ++m)
#pragma unroll
                for (int bj = 0; bj < 2; ++bj) E(cur.uc, ai * HALF + wr * 64 + m * 16 + fr, cur.colbase + bj * HALF + wc * 32, fq, acc[ai][bj][m][0], acc[ai][bj][m][1], rowv[ai][m]);
        }
        }
        if (!has_next) break;
        if constexpr (has_pf<Epi>::value) { nxt.uc.par = (ui + 1) & 1; E.prefetch(nxt.uc, nxt.colbase, (unsigned char*)lds + 131072 + 12288, wid, lane); }
        if (!(has_chain<Epi>::value && cur.uc.e == 0))
#pragma unroll
        for (int a = 0; a < 2; ++a)
#pragma unroll
            for (int b = 0; b < 2; ++b)
#pragma unroll
                for (int m = 0; m < 4; ++m)
#pragma unroll
                    for (int n = 0; n < 2; ++n) { f32x2 z0, z1; asm volatile("v_pk_mov_b32 %0, 0, 0" : "=v"(z0)); asm volatile("v_pk_mov_b32 %0, 0, 0" : "=v"(z1)); acc[a][b][m][n] = (f32x4){z0.x, z0.y, z1.x, z1.y}; }
        cur = nxt; cA = nA; cB = nB; ++ui;
        if constexpr (GATHER) {
#pragma unroll
            for (int h = 0; h < 2; ++h) { offc[h][0] = offn[h][0]; offc[h][1] = offn[h][1]; } }
        if (wr == 1) PG8_BAR;
    }
    PG8_WAIT_V(0);
    PG8_BAR;
#undef PG8_SA
#undef PG8_SB
#undef PG8_RAW
#undef PG8_STB
#undef PG8_STA
#undef PG8_LDA
#undef PG8_LDB
#undef PG8_MMA
#undef PG8_WAIT_V
#undef PG8_WAIT_L
#undef PG8_BAR
#undef PG8_SCHED
}
struct DenseSched { const void* A; const void* Bt; int RB; int pn0; StaticOrder so;
    __device__ __forceinline__ bool next(int i, GUnit& u) const { Unit t; if (!so.next(i, t)) return false;
        t.pn += pn0; u.A = (const char*)A + (size_t)t.pm * 256 * RB; u.B = (const char*)Bt + (size_t)t.pn * 256 * RB;
        u.uc.row0 = t.pm * 256; u.uc.e = 0; u.uc.idx0 = 0; u.uc.cnt = 0; u.uc.list = nullptr; u.colbase = t.pn * 256; return true; }
    __device__ __forceinline__ void gather_offsets(const GUnit&, const int (&)[2], const int (&)[2], unsigned (&)[2][2], int) const {}
};
struct ChainSched { const void* A0; const void* B0; const void* A1; const void* B1; int RB; StaticOrder so;
    __device__ __forceinline__ bool next(int i, GUnit& u) const { Unit t; if (!so.next(i >> 1, t)) return false; const int h = i & 1;
        u.A = (const char*)(h ? A1 : A0) + (size_t)t.pm * 256 * RB; u.B = (const char*)(h ? B1 : B0) + (size_t)t.pn * 256 * RB;
        u.uc.row0 = t.pm * 256; u.uc.e = h; u.uc.idx0 = 0; u.uc.cnt = 0; u.uc.list = nullptr; u.colbase = t.pn * 256; return true; }
    __device__ __forceinline__ void gather_offsets(const GUnit&, const int (&)[2], const int (&)[2], unsigned (&)[2][2], int) const {}
};
}
template <class Epi>
__device__ __forceinline__ void gemm_chain_fast(char* lds, const void* A0, const void* B0, const void* A1, const void* B1, int M, int N, int K, const Epi& E) {
    pg8::ChainSched S; S.A0 = A0; S.B0 = B0; S.A1 = A1; S.B1 = B1; S.RB = 2 * K; S.so.init(M / 256, N / 256, (int)gridDim.x, (int)blockIdx.x, WGM_DENSE);
    pg8::gemm_phase<Epi, pg8::ChainSched, false, false>((LAS unsigned char*)lds, K, S, E);
}
template <class Epi, bool F8 = false>
__device__ __forceinline__ void gemm_dense_fast(char* lds, const void* A, const void* Bt, int M, int N, int K, const Epi& E, int pn0 = 0) {
    pg8::DenseSched S; S.A = A; S.Bt = Bt; S.RB = F8 ? K : 2 * K; S.pn0 = pn0; S.so.init(M / 256, N / 256, (int)gridDim.x, (int)blockIdx.x, (N / 256 > 8) ? WGM_WIDE : WGM_DENSE);
    pg8::gemm_phase<Epi, pg8::DenseSched, false, F8>((LAS unsigned char*)lds, K, S, E);
}

struct NoRow {};
struct EpiNull { float* sink; typedef NoRow RowT;
    __device__ __forceinline__ NoRow row_pre(const UnitCtx&, int) const { return NoRow{}; }
    __device__ __forceinline__ void operator()(const UnitCtx& uc, int r, int cb, int fq, f32x4 v0, f32x4 v1, NoRow) const { if (v0[0] == 1.2345e-30f && v1[3] == 7.7e-31f) sink[0] = v0[1]; } };
struct EpiZ { bf16_t* Z; float* FL; const float* rstd; typedef float RowT;
    __device__ __forceinline__ float row_pre(const UnitCtx& uc, int r) const { return rstd[uc.row0 + r]; }
    __device__ __forceinline__ void operator()(const UnitCtx& uc, int r, int cb, int fq, f32x4 v0, f32x4 v1, float s) const {
        const int row = uc.row0 + r; v0 = v0 * s; v1 = v1 * s;
        bf16_t* zr = Z + (size_t)row * ZP + cb + 8 * fq;
        { const u32x2 a = pk4(v0), b = pk4(v1); *(u32x4*)zr = (u32x4){a.x, a.y, b.x, b.y}; }
        if (cb == OFF_FL && fq < 2) { float* f = FL + (size_t)row * 16 + 8 * fq; *(f32x4*)f = v0; *(f32x4*)(f + 4) = v1; }
    } };
struct EpiBf16 { bf16_t* O; int ldo; typedef NoRow RowT;
    __device__ __forceinline__ NoRow row_pre(const UnitCtx&, int) const { return NoRow{}; }
    __device__ __forceinline__ void operator()(const UnitCtx& uc, int r, int cb, int fq, f32x4 v0, f32x4 v1, NoRow) const {
        bf16_t* o = O + (size_t)(uc.row0 + r) * ldo + cb + 8 * fq; const u32x2 a = pk4(v0), b = pk4(v1); *(u32x4*)o = (u32x4){a.x, a.y, b.x, b.y};
    } };
struct EpiMixA { bf16_t* T; const bf16_t* Z; float sc; typedef NoRow RowT;
    __device__ __forceinline__ NoRow row_pre(const UnitCtx&, int) const { return NoRow{}; }
    __device__ __forceinline__ void operator()(const UnitCtx& uc, int r, int cb, int fq, f32x4 v0, f32x4 v1, NoRow) const {
        const int row = uc.row0 + r, c = cb + 8 * fq; const bf16_t* g = Z + (size_t)row * ZP + OFF_GM + c;
        const u32x4 gw = *(const u32x4*)g; const f32x4 g0 = unpk4((u32x2){gw.x, gw.y}), g1 = unpk4((u32x2){gw.z, gw.w}); f32x4 o0, o1;
#pragma unroll
        for (int j = 0; j < 4; ++j) { o0[j] = sigmoidf_(g0[j]) * v0[j] * sc; o1[j] = sigmoidf_(g1[j]) * v1[j] * sc; }
        bf16_t* t = T + (size_t)row * DM + c; { const u32x2 a = pk4(o0), b = pk4(o1); *(u32x4*)t = (u32x4){a.x, a.y, b.x, b.y}; }
    } };
struct EpiMixB { const bf16_t* T; const bf16_t* Z; unsigned char* MIXED; float sc; typedef NoRow RowT;
    __device__ __forceinline__ NoRow row_pre(const UnitCtx&, int) const { return NoRow{}; }
    __device__ __forceinline__ void operator()(const UnitCtx& uc, int r, int cb, int fq, f32x4 v0, f32x4 v1, NoRow) const {
        const int row = uc.row0 + r, c = cb + 8 * fq; const bf16_t* g = Z + (size_t)row * ZP + OFF_GF + c;
        const u32x4 gw = *(const u32x4*)g; const f32x4 g0 = unpk4((u32x2){gw.x, gw.y}), g1 = unpk4((u32x2){gw.z, gw.w}); const bf16_t* t = T + (size_t)row * DM + c;
        const u32x4 tw = *(const u32x4*)t; const f32x4 t0 = unpk4((u32x2){tw.x, tw.y}), t1 = unpk4((u32x2){tw.z, tw.w}); f32x4 o0, o1;
#pragma unroll
        for (int j = 0; j < 4; ++j) { o0[j] = (t0[j] + sigmoidf_(g0[j]) * v0[j] * sc); o1[j] = (t1[j] + sigmoidf_(g1[j]) * v1[j] * sc); }
        if (F8_P5) *(u32x2*)(MIXED + (size_t)row * DM + c) = (u32x2){pk4_fp8(o0 * F8_SX), pk4_fp8(o1 * F8_SX)};
        else { const u32x2 a = pk4(o0), b = pk4(o1); *(u32x4*)(MIXED + ((size_t)row * DM + c) * 2) = (u32x4){a.x, a.y, b.x, b.y}; }
    } };
struct EpiMixChain { static constexpr bool WHOLE = true; static constexpr bool CHAIN = true; typedef NoRow RowT; const bf16_t* Z; bf16_t* MIXED;
    __device__ __forceinline__ void whole(f32x4 (&acc)[2][2][4][2], const UnitCtx& uc, int colbase, int wr, int wc, int fr, int fq, float*) const {
        const bool first = uc.e == 0;
        u32x4 gq[2][2][2];
#define MIX_LD(i, slot) do { const int row_ = uc.row0 + ((i) >> 2) * 128 + wr * 64 + ((i) & 3) * 16 + fr; \
            _Pragma("unroll") for (int bj_ = 0; bj_ < 2; ++bj_) { const bf16_t* zp_ = Z + (size_t)row_ * ZP + colbase + bj_ * 128 + wc * 32 + 8 * fq; gq[slot][bj_][0] = *(const u32x4*)(zp_ + OFF_GF); if (first) gq[slot][bj_][1] = *(const u32x4*)(zp_ + OFF_GM); } } while (0)
        MIX_LD(0, 0);
#pragma unroll
        for (int i = 0; i < 8; ++i) { const int ai = i >> 2, m = i & 3; const int row = uc.row0 + ai * 128 + wr * 64 + m * 16 + fr;
            if (i + 1 < 8) MIX_LD(i + 1, (i + 1) & 1);
            __builtin_amdgcn_sched_barrier(0);
#pragma unroll
            for (int bj = 0; bj < 2; ++bj) { const u32x4 gw = gq[i & 1][bj][0]; const f32x4 f0 = unpk4((u32x2){gw.x, gw.y}), f1 = unpk4((u32x2){gw.z, gw.w});
                f32x4 d0, d1;
#pragma unroll
                for (int j = 0; j < 4; ++j) { d0[j] = 1.0f + __builtin_amdgcn_exp2f(-LOG2E * fmaxf(f0[j], -60.0f)); d1[j] = 1.0f + __builtin_amdgcn_exp2f(-LOG2E * fmaxf(f1[j], -60.0f)); }
                if (first) { const u32x4 mw = gq[i & 1][bj][1]; const f32x4 m0 = unpk4((u32x2){mw.x, mw.y}), m1 = unpk4((u32x2){mw.z, mw.w});
#pragma unroll
                    for (int j = 0; j < 4; ++j) { acc[ai][bj][m][0][j] *= sigmoidf_(m0[j]) * d0[j]; acc[ai][bj][m][1][j] *= sigmoidf_(m1[j]) * d1[j]; }
                } else { f32x4 o0, o1;
#pragma unroll
                    for (int j = 0; j < 4; ++j) { o0[j] = acc[ai][bj][m][0][j] * __builtin_amdgcn_rcpf(d0[j]); o1[j] = acc[ai][bj][m][1][j] * __builtin_amdgcn_rcpf(d1[j]); }
                    const u32x2 a = pk4(o0), b = pk4(o1); *(u32x4*)(MIXED + (size_t)row * DM + colbase + bj * 128 + wc * 32 + 8 * fq) = (u32x4){a.x, a.y, b.x, b.y}; } }
            __builtin_amdgcn_sched_barrier(0);
        }
#undef MIX_LD
    } };
struct EpiResid { const float* X; bf16_t* O; float sc; typedef NoRow RowT;
    __device__ __forceinline__ NoRow row_pre(const UnitCtx&, int) const { return NoRow{}; }
    static constexpr int PD = 4; struct PreT { f32x4 x0, x1; };
    __device__ __forceinline__ PreT pre(const UnitCtx& uc, int r, int cb, int fq) const { const size_t off = (size_t)(uc.row0 + r) * DM + cb + 8 * fq; PreT q; q.x0 = __builtin_nontemporal_load((const f32x4*)(X + off)); q.x1 = __builtin_nontemporal_load((const f32x4*)(X + off + 4)); return q; }
    __device__ __forceinline__ void post(const UnitCtx& uc, int r, int cb, int fq, f32x4 v0, f32x4 v1, NoRow, const PreT& q) const {
        const size_t off = (size_t)(uc.row0 + r) * DM + cb + 8 * fq;
        const u32x2 a = pk4(q.x0 + v0 * sc), b = pk4(q.x1 + v1 * sc); *(u32x4*)(O + off) = (u32x4){a.x, a.y, b.x, b.y};
    } };
struct EpiUp { bf16_t* H; const float* listr; const float* b_up; typedef float RowT;
    __device__ __forceinline__ float row_pre(const UnitCtx& uc, int r) const { const int idx = uc.idx0 + r; return (idx < uc.cnt) ? listr[(size_t)uc.e * NTOK + idx] : 0.f; }
    __device__ __forceinline__ void operator()(const UnitCtx& uc, int r, int cb, int fq, f32x4 v0, f32x4 v1, float rs) const {
        const int c = 16 * (cb >> 5) + 4 * fq; const float* bu = b_up + (size_t)uc.e * 2048 + c;
        const f32x4 bg = *(const f32x4*)bu, bb = *(const f32x4*)(bu + 1024); f32x4 o;
#pragma unroll
        for (int j = 0; j < 4; ++j) { float g = v0[j] * rs + bg[j], u = v1[j] * rs + bb[j]; g = fminf(g, 7.0f); u = fminf(fmaxf(u, -7.0f), 7.0f); o[j] = g * sigmoidf_(1.702f * g) * (u + 1.0f); }
        *(u32x2*)(H + (size_t)(uc.row0 + r) * EFF + c) = pk4(o);
    } };

struct EpiUpW { static constexpr bool WHOLE = true; static constexpr bool PF = true; typedef NoRow RowT; bf16_t* H; const float* listr; const float* b_up;
    __device__ __forceinline__ void prefetch(const UnitCtx& uc, int colbase, unsigned char* pf, int wid, int lane) const {
        asm volatile("" : "+v"(lane));
        LAS unsigned* dst = (LAS unsigned*)(pf + uc.par * 3072);
        if (wid == 0) __builtin_amdgcn_global_load_lds((const unsigned*)(listr + (size_t)uc.e * NTOK + uc.idx0 + lane * 4), dst, 16, 0, 0);
        else if (wid == 1) { const float* bp = b_up + (size_t)uc.e * 2048 + 128 * (colbase >> 8) + (lane & 31) * 4 + (lane >> 5) * 1024;
            __builtin_amdgcn_global_load_lds((const unsigned*)bp, (LAS unsigned*)(pf + uc.par * 3072 + 1024), 16, 0, 0); }
    }
    __device__ __forceinline__ void whole(f32x4 (&acc)[2][2][4][2], const UnitCtx& uc, int colbase, int wr, int wc, int fr, int fq, float* X) const {
        const int c = 128 * (colbase >> 8) + 32 * wc + 8 * fq; const float* pfb = X + 1024 + uc.par * 768; const float* bp = pfb + 256 + 32 * wc + 8 * fq - 0;
        float rs[2][4];
#pragma unroll
        for (int ai = 0; ai < 2; ++ai)
#pragma unroll
            for (int m = 0; m < 4; ++m) rs[ai][m] = pfb[ai * 128 + wr * 64 + m * 16 + fr];
        f32x4 bg0 = *(const f32x4*)bp, bg1 = *(const f32x4*)(bp + 4), bu0 = *(const f32x4*)(bp + 128), bu1 = *(const f32x4*)(bp + 132);
#pragma unroll
        for (int ai = 0; ai < 2; ++ai)
#pragma unroll
            for (int m = 0; m < 4; ++m) { const int idx = uc.idx0 + ai * 128 + wr * 64 + m * 16 + fr; rs[ai][m] = (idx < uc.cnt) ? rs[ai][m] * (1.0f / (F8_SX * F8_SW)) : 0.f; }
        bg0 *= F8_SH; bg1 *= F8_SH; bu0 += 1.0f; bu1 += 1.0f;
#pragma unroll
        for (int ai = 0; ai < 2; ++ai)
#pragma unroll
            for (int m = 0; m < 4; ++m) { const float r_ = rs[ai][m], r8 = r_ * F8_SH; f32x4 o[2];
#pragma unroll
                for (int n = 0; n < 2; ++n)
#pragma unroll
                    for (int j = 0; j < 4; ++j) { float g8 = acc[ai][0][m][n][j] * r8 + (n ? bg1[j] : bg0[j]), u1 = acc[ai][1][m][n][j] * r_ + (n ? bu1[j] : bu0[j]);
                        g8 = fminf(g8, 7.0f * F8_SH); u1 = __builtin_amdgcn_fmed3f(u1, -6.0f, 8.0f);
                        o[n][j] = g8 * __builtin_amdgcn_rcpf(1.0f + __builtin_amdgcn_exp2f(g8 * (-1.702f * LOG2E / F8_SH))) * u1; }
                *(u32x2*)((unsigned char*)H + (size_t)(uc.row0 + ai * 128 + wr * 64 + m * 16 + fr) * EFF + c) = (u32x2){pk4_fp8(o[0]), pk4_fp8(o[1])}; }
    } };
struct EpiDownW { static constexpr bool WHOLE = true; static constexpr bool PF = true; typedef NoRow RowT; bf16_t* Y; const float* listg; const float* b_down;
    __device__ __forceinline__ void prefetch(const UnitCtx& uc, int colbase, unsigned char* pf, int wid, int lane) const {
        asm volatile("" : "+v"(lane));
        unsigned char* d = pf + uc.par * 3072;
        if (wid == 0) __builtin_amdgcn_global_load_lds((const unsigned*)(uc.list + uc.idx0 + lane * 4), (LAS unsigned*)d, 16, 0, 0);
        else if (wid == 1) __builtin_amdgcn_global_load_lds((const unsigned*)(listg + (size_t)uc.e * NTOK + uc.idx0 + lane * 4), (LAS unsigned*)(d + 1024), 16, 0, 0);
        else if (wid == 2) __builtin_amdgcn_global_load_lds((const unsigned*)(b_down + (size_t)uc.e * 1024 + colbase + lane * 4), (LAS unsigned*)(d + 2048), 16, 0, 0);
    }
    __device__ __forceinline__ void whole(f32x4 (&acc)[2][2][4][2], const UnitCtx& uc, int colbase, int wr, int wc, int fr, int fq, float* X) const {
        const float* pfb = X + 1024 + uc.par * 768; const int* pfi = (const int*)pfb;
        int aid[2][4]; float gt[2][4];
#pragma unroll
        for (int ai = 0; ai < 2; ++ai)
#pragma unroll
            for (int m = 0; m < 4; ++m) { const int ri = ai * 128 + wr * 64 + m * 16 + fr; aid[ai][m] = pfi[ri]; gt[ai][m] = pfb[256 + ri]; }
        f32x4 bd[2][2];
#pragma unroll
        for (int bj = 0; bj < 2; ++bj) { const float* bp = pfb + 512 + 128 * bj + 32 * wc + 8 * fq; bd[bj][0] = *(const f32x4*)bp; bd[bj][1] = *(const f32x4*)(bp + 4); }
#pragma unroll
        for (int ai = 0; ai < 2; ++ai)
#pragma unroll
            for (int m = 0; m < 4; ++m) { asm volatile("" : "+v"(aid[ai][m]), "+v"(gt[ai][m])); const int idx = uc.idx0 + ai * 128 + wr * 64 + m * 16 + fr; if (!(idx < uc.cnt)) { aid[ai][m] = -1; gt[ai][m] = 0.f; } }
#pragma unroll
        for (int ai = 0; ai < 2; ++ai)
#pragma unroll
            for (int m = 0; m < 4; ++m) { if (aid[ai][m] < 0) continue; const float g = gt[ai][m]; bf16_t* y = Y + (size_t)aid[ai][m] * DM + colbase + 32 * wc + 8 * fq;
#pragma unroll
                for (int bj = 0; bj < 2; ++bj) { const u32x2 a = pk4((acc[ai][bj][m][0] * (1.0f / (F8_SH * F8_SW)) + bd[bj][0]) * g), b = pk4((acc[ai][bj][m][1] * (1.0f / (F8_SH * F8_SW)) + bd[bj][1]) * g); *(u32x4*)(y + 128 * bj) = (u32x4){a.x, a.y, b.x, b.y}; } }
    } };

struct EpiKVHead { static constexpr bool WHOLE = true; typedef NoRow RowT; bf16_t* KVM; const float* gkn; unsigned char* K8;
#if KVBAL && ATT_F8
    __device__ __forceinline__ void whole(f32x4 (&acc)[2][2][4][2], const UnitCtx& uc, int colbase, int wr, int wc, int fr, int fq, float* X) const {
#pragma unroll
        for (int ai = 0; ai < 2; ++ai)
#pragma unroll
            for (int m = 0; m < 4; ++m) { float ss = 0.f;
#pragma unroll
                for (int n = 0; n < 2; ++n) { const f32x4 v = acc[ai][0][m][n]; ss += (v[0] * v[0] + v[1] * v[1]) + (v[2] * v[2] + v[3] * v[3]); }
                ss += __shfl_xor(ss, 16); ss += __shfl_xor(ss, 32);
                if (fq == 0) X[(ai * 128 + wr * 64 + m * 16 + fr) * 4 + wc] = ss; }
        asm volatile("s_waitcnt lgkmcnt(0)" ::: "memory"); __builtin_amdgcn_s_barrier(); asm volatile("" ::: "memory");
        const int c = 32 * wc + 8 * fq; const f32x4 g0 = *(const f32x4*)(gkn + c), g1 = *(const f32x4*)(gkn + c + 4);
#pragma unroll
        for (int ai = 0; ai < 2; ++ai)
#pragma unroll
            for (int m = 0; m < 4; ++m) { const int r = ai * 128 + wr * 64 + m * 16 + fr; const size_t row = (size_t)(uc.row0 + r);
                const float rs = 16.0f * __builtin_amdgcn_rsqf(((X[r * 4] + X[r * 4 + 1]) + (X[r * 4 + 2] + X[r * 4 + 3])) * (1.0f / 128.0f) + EPS);
                *(u32x2*)(K8 + row * 1024 + (colbase >> 1) + c) = (u32x2){pk4_fp8(acc[ai][0][m][0] * rs * g0), pk4_fp8(acc[ai][0][m][1] * rs * g1)};
                { const u32x2 a = pk4(acc[ai][1][m][0]), b = pk4(acc[ai][1][m][1]); *(u32x4*)(KVM + row * 2048 + colbase + 128 + c) = (u32x4){a.x, a.y, b.x, b.y}; } }
    }
#else
    __device__ __forceinline__ void whole(f32x4 (&acc)[2][2][4][2], const UnitCtx& uc, int colbase, int wr, int wc, int fr, int fq, float* X) const {
        if (wc < 2) {
#pragma unroll
            for (int ai = 0; ai < 2; ++ai)
#pragma unroll
                for (int m = 0; m < 4; ++m) { float ss = 0.f;
#pragma unroll
                    for (int bj = 0; bj < 2; ++bj)
#pragma unroll
                        for (int n = 0; n < 2; ++n) { const f32x4 v = acc[ai][bj][m][n]; ss += (v[0] * v[0] + v[1] * v[1]) + (v[2] * v[2] + v[3] * v[3]); }
                    ss += __shfl_xor(ss, 16); ss += __shfl_xor(ss, 32);
                    if (fq == 0) X[(ai * 128 + wr * 64 + m * 16 + fr) * 4 + wc] = ss; }
        }
        asm volatile("s_waitcnt lgkmcnt(0)" ::: "memory"); __builtin_amdgcn_s_barrier(); asm volatile("" ::: "memory");
        f32x4 gv[2][2];
#pragma unroll
        for (int bj = 0; bj < 2; ++bj) { const int c = 64 * (wc & 1) + 32 * bj + 8 * fq; gv[bj][0] = *(const f32x4*)(gkn + c); gv[bj][1] = *(const f32x4*)(gkn + c + 4); }
#pragma unroll
        for (int ai = 0; ai < 2; ++ai)
#pragma unroll
            for (int m = 0; m < 4; ++m) { const int r = ai * 128 + wr * 64 + m * 16 + fr; float rs = 1.f;
                if (wc < 2) rs = __builtin_amdgcn_rsqf((X[r * 4] + X[r * 4 + 1]) * (1.0f / 128.0f) + EPS);
#pragma unroll
                for (int bj = 0; bj < 2; ++bj) { const int c = 64 * wc + 32 * bj + 8 * fq; f32x4 v0 = acc[ai][bj][m][0] * rs, v1 = acc[ai][bj][m][1] * rs;
                    if (wc < 2) { v0 = v0 * gv[bj][0]; v1 = v1 * gv[bj][1]; }
                    if (ATT_F8 && wc < 2) *(u32x2*)(K8 + (size_t)(uc.row0 + r) * 1024 + (colbase >> 1) + c) = (u32x2){pk4_fp8(v0 * 16.0f), pk4_fp8(v1 * 16.0f)};
                    else { const u32x2 a = pk4(v0), b = pk4(v1); *(u32x4*)(KVM + (size_t)(uc.row0 + r) * 2048 + colbase + c) = (u32x4){a.x, a.y, b.x, b.y}; } } }
    }
#endif
};
struct EpiQHead { static constexpr bool WHOLE = true; typedef NoRow RowT; bf16_t* QM; const float* gqn; const float* gqr; const f32x2* rope; unsigned char* QM8;
#if QPACK
    __device__ __forceinline__ void whole(f32x4 (&acc)[2][2][4][2], const UnitCtx& uc, int colbase, int wr, int wc, int fr, int fq, float* X) const {
        const int pn = colbase >> 8;
        if (pn < 4) {
#pragma unroll
            for (int ai = 0; ai < 2; ++ai)
#pragma unroll
                for (int m = 0; m < 4; ++m) { float ss = 0.f;
#pragma unroll
                    for (int bj = 0; bj < 2; ++bj)
#pragma unroll
                        for (int n = 0; n < 2; ++n) { const f32x4 v = acc[ai][bj][m][n]; ss += (v[0] * v[0] + v[1] * v[1]) + (v[2] * v[2] + v[3] * v[3]); }
                    ss += __shfl_xor(ss, 16); ss += __shfl_xor(ss, 32);
                    if (fq == 0) X[(ai * 128 + wr * 64 + m * 16 + fr) * 4 + wc] = ss; }
            asm volatile("s_waitcnt lgkmcnt(0)" ::: "memory"); __builtin_amdgcn_s_barrier(); asm volatile("" ::: "memory");
            const int h = 2 * pn + (wc >> 1), hc = 64 * (wc & 1), xo = wc & 2;
            f32x4 gq[2][2];
#pragma unroll
            for (int bj = 0; bj < 2; ++bj) { const int c = hc + 32 * bj + 8 * fq; gq[bj][0] = *(const f32x4*)(gqn + c); gq[bj][1] = *(const f32x4*)(gqn + c + 4); }
#pragma unroll
            for (int ai = 0; ai < 2; ++ai)
#pragma unroll
                for (int m = 0; m < 4; ++m) { const int r = ai * 128 + wr * 64 + m * 16 + fr; const int row = uc.row0 + r;
                    const float rs = C2_MLA * __builtin_amdgcn_rsqf((X[r * 4 + xo] + X[r * 4 + xo + 1]) * (1.0f / 128.0f) + EPS);
#pragma unroll
                    for (int bj = 0; bj < 2; ++bj) { const int c = hc + 32 * bj + 8 * fq;
                        const f32x4 v0 = acc[ai][bj][m][0] * rs * gq[bj][0], v1 = acc[ai][bj][m][1] * rs * gq[bj][1];
                        *(u32x2*)(QM8 + (size_t)row * 1536 + h * 192 + c) = (u32x2){pk4_fp8(v0 * 64.0f), pk4_fp8(v1 * 64.0f)}; } }
        } else {
            const int h = 4 * (pn - 4) + wc;
            f32x4 g1[2], g2[2];
#pragma unroll
            for (int n = 0; n < 2; ++n) { g1[n] = *(const f32x4*)(gqr + 8 * fq + 4 * n); g2[n] = *(const f32x4*)(gqr + 32 + 8 * fq + 4 * n); }
            f32x4 rc[2][4];
#define ROPE_LD(i, slot) do { const int row_ = uc.row0 + ((i) >> 2) * 128 + wr * 64 + ((i) & 3) * 16 + fr; const f32x4* rp_ = (const f32x4*)(rope + (size_t)(row_ & (SEQ - 1)) * 32 + 8 * fq); \
                _Pragma("unroll") for (int k_ = 0; k_ < 4; ++k_) rc[slot][k_] = rp_[k_]; } while (0)
            ROPE_LD(0, 0);
#pragma unroll
            for (int i = 0; i < 8; ++i) { const int ai = i >> 2, m = i & 3; const int r = ai * 128 + wr * 64 + m * 16 + fr; const int row = uc.row0 + r;
                if (i + 1 < 8) ROPE_LD(i + 1, (i + 1) & 1);
                __builtin_amdgcn_sched_barrier(0);
                float ss = 0.f;
#pragma unroll
                for (int bj = 0; bj < 2; ++bj)
#pragma unroll
                    for (int n = 0; n < 2; ++n) { const f32x4 v = acc[ai][bj][m][n]; ss += (v[0] * v[0] + v[1] * v[1]) + (v[2] * v[2] + v[3] * v[3]); }
                ss += __shfl_xor(ss, 16); ss += __shfl_xor(ss, 32);
                const float rs = C2_MLA * __builtin_amdgcn_rsqf(ss * (1.0f / 64.0f) + EPS);
                f32x4 o1[2], o2[2];
#pragma unroll
                for (int n = 0; n < 2; ++n)
#pragma unroll
                    for (int j = 0; j < 4; ++j) { const float y1 = acc[ai][0][m][n][j] * rs * g1[n][j], y2 = acc[ai][1][m][n][j] * rs * g2[n][j]; const f32x4 q4 = rc[i & 1][(4 * n + j) >> 1]; const float cx = q4[(j & 1) * 2], cy = q4[(j & 1) * 2 + 1];
                        o1[n][j] = y1 * cx - y2 * cy; o2[n][j] = y2 * cx + y1 * cy; }
                unsigned char* q8 = QM8 + (size_t)row * 1536 + h * 192; *(u32x2*)(q8 + 128 + 8 * fq) = (u32x2){pk4_fp8(o1[0] * 64.0f), pk4_fp8(o1[1] * 64.0f)}; *(u32x2*)(q8 + 160 + 8 * fq) = (u32x2){pk4_fp8(o2[0] * 64.0f), pk4_fp8(o2[1] * 64.0f)};
                __builtin_amdgcn_sched_barrier(0);
            }
#undef ROPE_LD
        }
    }
#else
    __device__ __forceinline__ void whole(f32x4 (&acc)[2][2][4][2], const UnitCtx& uc, int colbase, int wr, int wc, int fr, int fq, float* X) const {
        const int h = colbase >> 8;
        if (wc < 3) {
#pragma unroll
            for (int ai = 0; ai < 2; ++ai)
#pragma unroll
                for (int m = 0; m < 4; ++m) { float ss = 0.f;
#pragma unroll
                    for (int bj = 0; bj < 2; ++bj)
#pragma unroll
                        for (int n = 0; n < 2; ++n) { const f32x4 v = acc[ai][bj][m][n]; ss += (v[0] * v[0] + v[1] * v[1]) + (v[2] * v[2] + v[3] * v[3]); }
                    ss += __shfl_xor(ss, 16); ss += __shfl_xor(ss, 32);
                    if (fq == 0) X[(ai * 128 + wr * 64 + m * 16 + fr) * 4 + wc] = ss; }
        }
        asm volatile("s_waitcnt lgkmcnt(0)" ::: "memory"); __builtin_amdgcn_s_barrier(); asm volatile("" ::: "memory");
        if (wc == 3) return;
        if (wc < 2) {
            f32x4 gq[2][2];
#pragma unroll
            for (int bj = 0; bj < 2; ++bj) { const int c = 64 * wc + 32 * bj + 8 * fq; gq[bj][0] = *(const f32x4*)(gqn + c); gq[bj][1] = *(const f32x4*)(gqn + c + 4); }
#pragma unroll
            for (int ai = 0; ai < 2; ++ai)
#pragma unroll
                for (int m = 0; m < 4; ++m) { const int r = ai * 128 + wr * 64 + m * 16 + fr; const int row = uc.row0 + r;
                    const float rs = C2_MLA * __builtin_amdgcn_rsqf((X[r * 4] + X[r * 4 + 1]) * (1.0f / 128.0f) + EPS);
#pragma unroll
                    for (int bj = 0; bj < 2; ++bj) { const int c = 64 * wc + 32 * bj + 8 * fq;
                        const f32x4 v0 = acc[ai][bj][m][0] * rs * gq[bj][0], v1 = acc[ai][bj][m][1] * rs * gq[bj][1];
                        if (ATT_F8) *(u32x2*)(QM8 + (size_t)row * 1536 + h * 192 + c) = (u32x2){pk4_fp8(v0 * 64.0f), pk4_fp8(v1 * 64.0f)};
                        else { bf16_t* qrow = QM + (size_t)row * 1536 + h * 192; const u32x2 a = pk4(v0), b = pk4(v1); *(u32x4*)(qrow + c) = (u32x4){a.x, a.y, b.x, b.y}; } } }
        } else {
            f32x4 g1[2], g2[2];
#pragma unroll
            for (int n = 0; n < 2; ++n) { g1[n] = *(const f32x4*)(gqr + 8 * fq + 4 * n); g2[n] = *(const f32x4*)(gqr + 32 + 8 * fq + 4 * n); }
            f32x4 rc[2][4];
#define ROPE_LD(i, slot) do { const int row_ = uc.row0 + ((i) >> 2) * 128 + wr * 64 + ((i) & 3) * 16 + fr; const f32x4* rp_ = (const f32x4*)(rope + (size_t)(row_ & (SEQ - 1)) * 32 + 8 * fq); \
                _Pragma("unroll") for (int k_ = 0; k_ < 4; ++k_) rc[slot][k_] = rp_[k_]; } while (0)
            ROPE_LD(0, 0);
#pragma unroll
            for (int i = 0; i < 8; ++i) { const int ai = i >> 2, m = i & 3; const int r = ai * 128 + wr * 64 + m * 16 + fr; const int row = uc.row0 + r;
                if (i + 1 < 8) ROPE_LD(i + 1, (i + 1) & 1);
                __builtin_amdgcn_sched_barrier(0);
                const float rs = C2_MLA * __builtin_amdgcn_rsqf(X[r * 4 + 2] * (1.0f / 64.0f) + EPS);
                f32x4 o1[2], o2[2];
#pragma unroll
                for (int n = 0; n < 2; ++n)
#pragma unroll
                    for (int j = 0; j < 4; ++j) { const float y1 = acc[ai][0][m][n][j] * rs * g1[n][j], y2 = acc[ai][1][m][n][j] * rs * g2[n][j]; const f32x4 q4 = rc[i & 1][(4 * n + j) >> 1]; const float cx = q4[(j & 1) * 2], cy = q4[(j & 1) * 2 + 1];
                        o1[n][j] = y1 * cx - y2 * cy; o2[n][j] = y2 * cx + y1 * cy; }
                if (ATT_F8) { unsigned char* q8 = QM8 + (size_t)row * 1536 + h * 192; *(u32x2*)(q8 + 128 + 8 * fq) = (u32x2){pk4_fp8(o1[0] * 64.0f), pk4_fp8(o1[1] * 64.0f)}; *(u32x2*)(q8 + 160 + 8 * fq) = (u32x2){pk4_fp8(o2[0] * 64.0f), pk4_fp8(o2[1] * 64.0f)}; }
                else { bf16_t* qrow = QM + (size_t)row * 1536 + h * 192;
                    { const u32x2 a = pk4(o1[0]), b = pk4(o1[1]); *(u32x4*)(qrow + 128 + 8 * fq) = (u32x4){a.x, a.y, b.x, b.y}; }
                    { const u32x2 a = pk4(o2[0]), b = pk4(o2[1]); *(u32x4*)(qrow + 160 + 8 * fq) = (u32x4){a.x, a.y, b.x, b.y}; } }
                __builtin_amdgcn_sched_barrier(0);
            }
#undef ROPE_LD
        }
    }
#endif
};

struct EpiZHead { static constexpr bool WHOLE = true; static constexpr bool PF = true; typedef NoRow RowT;
    bf16_t* Z; bf16_t* CQN; bf16_t* CKVN; bf16_t* KR; unsigned char* KR8; unsigned char* FQ8; unsigned char* FK8; float* LF; const float* rstd; const float* gkr; const float* gfq; const float* gfk; const float* fbias; const f32x2* rope;
    __device__ __forceinline__ void prefetch(const UnitCtx& uc, int colbase, unsigned char* pf, int wid, int lane) const {
        asm volatile("" : "+v"(lane));
        if (wid == 0) __builtin_amdgcn_global_load_lds((const unsigned*)(rstd + uc.row0 + lane * 4), (LAS unsigned*)(pf + uc.par * 3072), 16, 0, 0);
    }
    __device__ __forceinline__ void whole(f32x4 (&acc)[2][2][4][2], const UnitCtx& uc, int colbase, int wr, int wc, int fr, int fq, float* X) const {
        const int pn = colbase >> 8; const float* pfb = X + 1024 + uc.par * 768;
        float s1[2][4];
#pragma unroll
        for (int ai = 0; ai < 2; ++ai)
#pragma unroll
            for (int m = 0; m < 4; ++m) s1[ai][m] = pfb[ai * 128 + wr * 64 + m * 16 + fr] * ((F8_P1 && pn >= P1_F8_TILE0) ? 1.0f / (F8_SX * F8_SW) : 1.0f);
        if (pn < 2) {
#pragma unroll
            for (int ai = 0; ai < 2; ++ai)
#pragma unroll
                for (int m = 0; m < 4; ++m) { float ss = 0.f;
#pragma unroll
                    for (int bj = 0; bj < 2; ++bj)
#pragma unroll
                        for (int n = 0; n < 2; ++n) { const f32x4 v = acc[ai][bj][m][n]; ss += (v[0] * v[0] + v[1] * v[1]) + (v[2] * v[2] + v[3] * v[3]); }
                    ss += __shfl_xor(ss, 16); ss += __shfl_xor(ss, 32);
                    if (fq == 0) X[(ai * 128 + wr * 64 + m * 16 + fr) * 4 + wc] = ss; }
            asm volatile("s_waitcnt lgkmcnt(0)" ::: "memory"); __builtin_amdgcn_s_barrier(); asm volatile("" ::: "memory");
            bf16_t* O = pn ? CKVN : CQN;
#pragma unroll
            for (int ai = 0; ai < 2; ++ai)
#pragma unroll
                for (int m = 0; m < 4; ++m) { const int r = ai * 128 + wr * 64 + m * 16 + fr; const float s = s1[ai][m];
                    const float tot = (X[r * 4] + X[r * 4 + 1]) + (X[r * 4 + 2] + X[r * 4 + 3]); const float rn = s * __builtin_amdgcn_rsqf(s * s * tot * (1.0f / 256.0f) + EPS);
#pragma unroll
                    for (int bj = 0; bj < 2; ++bj) { const int c = 64 * wc + 32 * bj + 8 * fq; const u32x2 a = pk4(acc[ai][bj][m][0] * rn), b = pk4(acc[ai][bj][m][1] * rn);
                        *(u32x4*)(O + (size_t)(uc.row0 + r) * 256 + c) = (u32x4){a.x, a.y, b.x, b.y}; } }
            return;
        }
        const int G = (colbase >> 6) + wc, gc = 64 * G;
        if (G >= 8 && G < 41) {
            f32x4 gg[2][2];
            if (G != 8) { const float* gp0 = (G < 25) ? gfq : gfk;
#pragma unroll
                for (int bj = 0; bj < 2; ++bj) { gg[bj][0] = *(const f32x4*)(gp0 + 32 * bj + 8 * fq); gg[bj][1] = *(const f32x4*)(gp0 + 32 * bj + 8 * fq + 4); } }
#pragma unroll
            for (int ai = 0; ai < 2; ++ai)
#pragma unroll
                for (int m = 0; m < 4; ++m) { const int row = uc.row0 + ai * 128 + wr * 64 + m * 16 + fr; const float s = s1[ai][m]; float ss = 0.f;
#pragma unroll
                    for (int bj = 0; bj < 2; ++bj)
#pragma unroll
                        for (int n = 0; n < 2; ++n) { const f32x4 v = acc[ai][bj][m][n]; ss += (v[0] * v[0] + v[1] * v[1]) + (v[2] * v[2] + v[3] * v[3]); }
                    ss += __shfl_xor(ss, 16); ss += __shfl_xor(ss, 32);
                    const float rn = s * __builtin_amdgcn_rsqf(s * s * ss * (1.0f / 64.0f) + EPS);
                    if (G == 8) { const int pos = row & (SEQ - 1); const f32x2* rt = rope + (size_t)pos * 32 + 8 * fq; f32x4 o1[2], o2[2];
#pragma unroll
                        for (int n = 0; n < 2; ++n) { const f32x4 g1 = *(const f32x4*)(gkr + 8 * fq + 4 * n), g2 = *(const f32x4*)(gkr + 32 + 8 * fq + 4 * n);
#pragma unroll
                            for (int j = 0; j < 4; ++j) { const float y1 = acc[ai][0][m][n][j] * rn * g1[j], y2 = acc[ai][1][m][n][j] * rn * g2[j]; const f32x2 cs = rt[4 * n + j];
                                o1[n][j] = y1 * cs.x - y2 * cs.y; o2[n][j] = y2 * cs.x + y1 * cs.y; } }
                        if (ATT_F8) { *(u32x2*)(KR8 + (size_t)row * 64 + 8 * fq) = (u32x2){pk4_fp8(o1[0] * 16.0f), pk4_fp8(o1[1] * 16.0f)}; *(u32x2*)(KR8 + (size_t)row * 64 + 32 + 8 * fq) = (u32x2){pk4_fp8(o2[0] * 16.0f), pk4_fp8(o2[1] * 16.0f)}; }
                        else {
                        { const u32x2 a = pk4(o1[0]), b = pk4(o1[1]); *(u32x4*)(KR + (size_t)row * 64 + 8 * fq) = (u32x4){a.x, a.y, b.x, b.y}; }
                        { const u32x2 a = pk4(o2[0]), b = pk4(o2[1]); *(u32x4*)(KR + (size_t)row * 64 + 32 + 8 * fq) = (u32x4){a.x, a.y, b.x, b.y}; } }
                    } else { const bool isq = G < 25; const float* gp = isq ? gfq : gfk; const float rq = isq ? rn * C2_FOX : rn;
#pragma unroll
                        for (int bj = 0; bj < 2; ++bj) { const int c = 32 * bj + 8 * fq; const f32x4 v0 = acc[ai][bj][m][0] * rq * gg[bj][0], v1 = acc[ai][bj][m][1] * rq * gg[bj][1];
                            if (ATT_F8) { unsigned char* d8 = (isq ? FQ8 + (size_t)row * 1024 + (G - 9) * 64 : FK8 + (size_t)row * 1024 + (G - 25) * 64) + c; const float s8 = isq ? 64.0f : 16.0f;
                                *(u32x2*)d8 = (u32x2){pk4_fp8(v0 * s8), pk4_fp8(v1 * s8)}; }
                            else { const u32x2 a = pk4(v0), b = pk4(v1); *(u32x4*)(Z + (size_t)row * ZP + gc + c) = (u32x4){a.x, a.y, b.x, b.y}; } } } }
            return;
        }
#pragma unroll
        for (int ai = 0; ai < 2; ++ai)
#pragma unroll
            for (int m = 0; m < 4; ++m) { const int row = uc.row0 + ai * 128 + wr * 64 + m * 16 + fr; const float s = s1[ai][m];
#pragma unroll
                for (int bj = 0; bj < 2; ++bj) { const int c = 32 * bj + 8 * fq; const f32x4 v0 = acc[ai][bj][m][0] * s, v1 = acc[ai][bj][m][1] * s;
                    if (G == 57 && bj == 0 && fq < 2) { const f32x4 b0 = *(const f32x4*)(fbias + 8 * fq), b1 = *(const f32x4*)(fbias + 8 * fq + 4); f32x4 l0, l1;
#pragma unroll
                        for (int j = 0; j < 4; ++j) { const float x0 = v0[j] + b0[j], x1 = v1[j] + b1[j]; l0[j] = fminf(x0, 0.f) - log1pf(__expf(-fabsf(x0))); l1[j] = fminf(x1, 0.f) - log1pf(__expf(-fabsf(x1))); }
                        float* lf = LF + (size_t)row * 16 + 8 * fq; *(f32x4*)lf = l0; *(f32x4*)(lf + 4) = l1; }
                    const u32x2 a = pk4(v0), b = pk4(v1);
                    if (G >= 57) __builtin_nontemporal_store((u32x4){a.x, a.y, b.x, b.y}, (u32x4*)(Z + (size_t)row * ZP + gc + c));
                    else *(u32x4*)(Z + (size_t)row * ZP + gc + c) = (u32x4){a.x, a.y, b.x, b.y}; } }
    } };
struct AidGate { int aid; float g; };
struct EpiDown { bf16_t* Y; const float* gate; const float* b_down; typedef AidGate RowT;
    __device__ __forceinline__ AidGate row_pre(const UnitCtx& uc, int r) const { const int idx = uc.idx0 + r; AidGate q; const bool ok = idx < uc.cnt; q.aid = ok ? uc.list[idx] : -1; q.g = ok ? gate[(size_t)uc.e * NTOK + idx] : 0.f; return q; }
    __device__ __forceinline__ void operator()(const UnitCtx& uc, int r, int cb, int fq, f32x4 v0, f32x4 v1, AidGate ag) const {
        if (ag.aid < 0) return;
        const int aid = ag.aid; const float g = ag.g; const int c = cb + 8 * fq; const float* bd = b_down + (size_t)uc.e * 1024 + c;
        const f32x4 o0 = (v0 + *(const f32x4*)bd) * g, o1 = (v1 + *(const f32x4*)(bd + 4)) * g;
        bf16_t* y = Y + (size_t)aid * DM + c; { const u32x2 a = pk4(o0), b = pk4(o1); *(u32x4*)y = (u32x4){a.x, a.y, b.x, b.y}; }
    } };
struct EpiF32 { bf16_t* T; typedef NoRow RowT;
    __device__ __forceinline__ NoRow row_pre(const UnitCtx&, int) const { return NoRow{}; }
    __device__ __forceinline__ void operator()(const UnitCtx& uc, int r, int cb, int fq, f32x4 v0, f32x4 v1, NoRow) const {
        bf16_t* t = T + (size_t)(uc.row0 + r) * DM + cb + 8 * fq; const u32x2 a = pk4(v0), b = pk4(v1); *(u32x4*)t = (u32x4){a.x, a.y, b.x, b.y};
    } };
struct EpiPle { float* O; const bf16_t* X2; const bf16_t* T; const float* rstd3; typedef float RowT;
    __device__ __forceinline__ float row_pre(const UnitCtx& uc, int r) const { return rstd3[uc.row0 + r] * (F8_PLE ? 1.0f / (F8_SX * F8_SW) : 1.0f); }
    static constexpr int PD = 4; struct PreT { u32x4 tw, xw; };
    __device__ __forceinline__ PreT pre(const UnitCtx& uc, int r, int cb, int fq) const { const size_t off = (size_t)(uc.row0 + r) * DM + cb + 8 * fq; PreT q; q.tw = *(const u32x4*)(T + off); q.xw = *(const u32x4*)(X2 + off); return q; }
    __device__ __forceinline__ void post(const UnitCtx& uc, int r, int cb, int fq, f32x4 v0, f32x4 v1, float rs, const PreT& q) const {
        const int row = uc.row0 + r; const size_t off = (size_t)row * DM + cb + 8 * fq;
        const u32x4 tw = q.tw, xw = q.xw; const f32x4 t0 = unpk4((u32x2){tw.x, tw.y}), t1 = unpk4((u32x2){tw.z, tw.w}); f32x4 x0 = unpk4((u32x2){xw.x, xw.y}), x1 = unpk4((u32x2){xw.z, xw.w});
#pragma unroll
        for (int j = 0; j < 4; ++j) { x0[j] += sigmoidf_(rs * v0[j]) * t0[j]; x1[j] += sigmoidf_(rs * v1[j]) * t1[j]; }
        *(f32x4*)(O + off) = x0; *(f32x4*)(O + off + 4) = x1;
    } };

__device__ __forceinline__ void phase_post1(const Args& a, int gw, int ngw, int lane) {
    unsigned char* ws = a.ws; bf16_t* Z = (bf16_t*)(ws + WS_Z); bf16_t* CQN = (bf16_t*)(ws + WS_CQN); bf16_t* CKVN = (bf16_t*)(ws + WS_CKVN); bf16_t* KR = (bf16_t*)(ws + WS_KR);
    const float* FL = (const float*)(ws + WS_FL); float* LF = (float*)(ws + WS_LF);
    const float* g_kr = a.in[11]; const float* g_fq = a.in[12]; const float* g_fk = a.in[13]; const float* fbias = a.in[14];
    const float gkr = g_kr[lane];
    float gq[16], gk[16];
#pragma unroll
    for (int j = 0; j < 16; ++j) { gq[j] = g_fq[(lane & 3) * 16 + j] * C2_FOX; gk[j] = g_fk[(lane & 3) * 16 + j]; }
    for (int m = gw; m < NTOK; m += ngw) {
        bf16_t* zr = Z + (size_t)m * ZP; const int pos = m & (SEQ - 1);
#pragma unroll
        for (int w = 0; w < 2; ++w) {
            const f32x4 v = unpk4(*((const u32x2*)(zr + (w ? OFF_CKV : OFF_CQ)) + lane));
            const float ss = wave_sum((v[0] * v[0] + v[1] * v[1]) + (v[2] * v[2] + v[3] * v[3]));
            const float rs = __builtin_amdgcn_rsqf(ss * (1.0f / 256.0f) + EPS);
            *((u32x2*)((w ? CKVN : CQN) + (size_t)m * 256) + lane) = pk4(v * rs);
        }
        {
            const float v = bf2f(zr[OFF_KR + lane]); const float ss = wave_sum(v * v); const float rs = __builtin_amdgcn_rsqf(ss * (1.0f / 64.0f) + EPS);
            const float y = v * rs * gkr; const float other = __shfl_xor(y, 32);
            float c, s; rope_cs(pos, lane & 31, c, s);
            const float o = (lane < 32) ? (y * c - other * s) : (y * c + other * s);
            KR[(size_t)m * 64 + lane] = (bf16_t)f2bf(o);
        }
#pragma unroll
        for (int w = 0; w < 2; ++w) {
            bf16_t* p = zr + (w ? OFF_FK : OFF_FQ) + lane * 16;
            const u32x4 r0 = *(const u32x4*)p, r1 = *(const u32x4*)(p + 8); float v[16];
            v[0] = bf2f(r0.x & 0xffffu); v[1] = bf2f(r0.x >> 16); v[2] = bf2f(r0.y & 0xffffu); v[3] = bf2f(r0.y >> 16); v[4] = bf2f(r0.z & 0xffffu); v[5] = bf2f(r0.z >> 16); v[6] = bf2f(r0.w & 0xffffu); v[7] = bf2f(r0.w >> 16);
            v[8] = bf2f(r1.x & 0xffffu); v[9] = bf2f(r1.x >> 16); v[10] = bf2f(r1.y & 0xffffu); v[11] = bf2f(r1.y >> 16); v[12] = bf2f(r1.z & 0xffffu); v[13] = bf2f(r1.z >> 16); v[14] = bf2f(r1.w & 0xffffu); v[15] = bf2f(r1.w >> 16);
            float ss = 0.f;
#pragma unroll
            for (int j = 0; j < 16; ++j) ss += v[j] * v[j];
            ss += __shfl_xor(ss, 1); ss += __shfl_xor(ss, 2);
            const float rs = __builtin_amdgcn_rsqf(ss * (1.0f / 64.0f) + EPS);
            u32x4 o0, o1;
#define PP(i) pk2(v[i] * rs * (w ? gk[i] : gq[i]), v[i + 1] * rs * (w ? gk[i + 1] : gq[i + 1]))
            o0.x = PP(0); o0.y = PP(2); o0.z = PP(4); o0.w = PP(6); o1.x = PP(8); o1.y = PP(10); o1.z = PP(12); o1.w = PP(14);
#undef PP
            *(u32x4*)p = o0; *(u32x4*)(p + 8) = o1;
        }
        if (lane < 16) { const float xv = FL[(size_t)m * 16 + lane] + fbias[lane]; LF[(size_t)m * 16 + lane] = fminf(xv, 0.f) - log1pf(__expf(-fabsf(xv))); }
    }
}
__device__ __forceinline__ void phase_scan(const Args& a, char* lds, int wave, int lane) {
    const float* LF = (const float*)(a.ws + WS_LF); float* FC = (float*)(a.ws + WS_FC); float* wt = (float*)(lds + 131072 + 12288);
    for (int it = blockIdx.x; it < BATCH * 16; it += gridDim.x) {
        const int b = it >> 4, h = it & 15, t = wave * 64 + lane; const float* src = LF + ((size_t)b * SEQ + (size_t)t * 16) * 16 + h;
        float v[16];
#pragma unroll
        for (int i = 0; i < 16; ++i) v[i] = src[(size_t)i * 16];
#pragma unroll
        for (int i = 1; i < 16; ++i) v[i] += v[i - 1];
        float incl = v[15];
#pragma unroll
        for (int o = 1; o < 64; o <<= 1) { const float u = __shfl_up(incl, o); if (lane >= o) incl += u; }
        if (lane == 63) wt[wave] = incl;
        __syncthreads();
        float base = incl - v[15];
        for (int w = 0; w < wave; ++w) base += wt[w];
        float* dst = FC + ((size_t)b * 16 + h) * SEQ + t * 16;
#pragma unroll
        for (int i = 0; i < 16; i += 4) *(f32x4*)(dst + i) = (f32x4){(base + v[i]) * LOG2E, (base + v[i + 1]) * LOG2E, (base + v[i + 2]) * LOG2E, (base + v[i + 3]) * LOG2E};
#if FOX_BIAS_MFMA
        u32x4* rec = (u32x4*)(a.ws + WS_FCR) + ((size_t)b * 16 + h) * SEQ + t * 16;
#pragma unroll
        for (int i = 0; i < 16; ++i) { const float x = (base + v[i]) * LOG2E; const unsigned b1 = f2bf(x); const float r1 = x - bf2f(b1); const unsigned b2 = f2bf(r1); const unsigned b3 = f2bf(r1 - bf2f(b2));
            rec[i] = (u32x4){0x3f803f80u, 0x3f80u | (b1 << 16), b2 | (b3 << 16), 0u}; }
#endif
        __syncthreads();
    }
}
__device__ __forceinline__ void phase_post2(const Args& a, int gw, int ngw, int lane) {
    unsigned char* ws = a.ws; bf16_t* QM = (bf16_t*)(ws + WS_QM); bf16_t* KVM = (bf16_t*)(ws + WS_KVM);
    const float* g_qn = a.in[8]; const float* g_qr = a.in[9]; const float* g_kn = a.in[10];
    const int sub = lane & 7;
    float gn[16], gr[8], gkn[16];
#pragma unroll
    for (int j = 0; j < 16; ++j) { gn[j] = g_qn[sub * 16 + j] * C2_MLA; gkn[j] = g_kn[sub * 16 + j]; }
#pragma unroll
    for (int j = 0; j < 8; ++j) gr[j] = g_qr[sub * 8 + j] * C2_MLA;
    for (int m = gw; m < NTOK; m += ngw) {
        const int pos = m & (SEQ - 1);
        bf16_t* qh = QM + (size_t)m * 1536 + (lane >> 3) * 192;
        {
            bf16_t* p = qh + sub * 16; const u32x4 r0 = *(const u32x4*)p, r1 = *(const u32x4*)(p + 8); float v[16];
            v[0] = bf2f(r0.x & 0xffffu); v[1] = bf2f(r0.x >> 16); v[2] = bf2f(r0.y & 0xffffu); v[3] = bf2f(r0.y >> 16); v[4] = bf2f(r0.z & 0xffffu); v[5] = bf2f(r0.z >> 16); v[6] = bf2f(r0.w & 0xffffu); v[7] = bf2f(r0.w >> 16);
            v[8] = bf2f(r1.x & 0xffffu); v[9] = bf2f(r1.x >> 16); v[10] = bf2f(r1.y & 0xffffu); v[11] = bf2f(r1.y >> 16); v[12] = bf2f(r1.z & 0xffffu); v[13] = bf2f(r1.z >> 16); v[14] = bf2f(r1.w & 0xffffu); v[15] = bf2f(r1.w >> 16);
            float ss = 0.f;
#pragma unroll
            for (int j = 0; j < 16; ++j) ss += v[j] * v[j];
            ss += __shfl_xor(ss, 1); ss += __shfl_xor(ss, 2); ss += __shfl_xor(ss, 4);
            const float rs = __builtin_amdgcn_rsqf(ss * (1.0f / 128.0f) + EPS);
            u32x4 o0, o1;
#define PP(i) pk2(v[i] * rs * gn[i], v[i + 1] * rs * gn[i + 1])
            o0.x = PP(0); o0.y = PP(2); o0.z = PP(4); o0.w = PP(6); o1.x = PP(8); o1.y = PP(10); o1.z = PP(12); o1.w = PP(14);
#undef PP
            *(u32x4*)p = o0; *(u32x4*)(p + 8) = o1;
        }
        {
            bf16_t* p = qh + 128 + sub * 8; const u32x4 r0 = *(const u32x4*)p; float v[8];
            v[0] = bf2f(r0.x & 0xffffu); v[1] = bf2f(r0.x >> 16); v[2] = bf2f(r0.y & 0xffffu); v[3] = bf2f(r0.y >> 16); v[4] = bf2f(r0.z & 0xffffu); v[5] = bf2f(r0.z >> 16); v[6] = bf2f(r0.w & 0xffffu); v[7] = bf2f(r0.w >> 16);
            float ss = 0.f;
#pragma unroll
            for (int j = 0; j < 8; ++j) ss += v[j] * v[j];
            ss += __shfl_xor(ss, 1); ss += __shfl_xor(ss, 2); ss += __shfl_xor(ss, 4);
            const float rs = __builtin_amdgcn_rsqf(ss * (1.0f / 64.0f) + EPS); float o[8];
#pragma unroll
            for (int j = 0; j < 8; ++j) { const float y = v[j] * rs * gr[j]; const float other = __shfl_xor(y, 4); float c, s; rope_cs(pos, (sub & 3) * 8 + j, c, s);
                o[j] = (sub < 4) ? (y * c - other * s) : (y * c + other * s); }
            u32x4 w; w.x = pk2(o[0], o[1]); w.y = pk2(o[2], o[3]); w.z = pk2(o[4], o[5]); w.w = pk2(o[6], o[7]); *(u32x4*)p = w;
        }
        {
            bf16_t* p = KVM + (size_t)m * 2048 + (lane >> 3) * 256 + sub * 16; const u32x4 r0 = *(const u32x4*)p, r1 = *(const u32x4*)(p + 8); float v[16];
            v[0] = bf2f(r0.x & 0xffffu); v[1] = bf2f(r0.x >> 16); v[2] = bf2f(r0.y & 0xffffu); v[3] = bf2f(r0.y >> 16); v[4] = bf2f(r0.z & 0xffffu); v[5] = bf2f(r0.z >> 16); v[6] = bf2f(r0.w & 0xffffu); v[7] = bf2f(r0.w >> 16);
            v[8] = bf2f(r1.x & 0xffffu); v[9] = bf2f(r1.x >> 16); v[10] = bf2f(r1.y & 0xffffu); v[11] = bf2f(r1.y >> 16); v[12] = bf2f(r1.z & 0xffffu); v[13] = bf2f(r1.z >> 16); v[14] = bf2f(r1.w & 0xffffu); v[15] = bf2f(r1.w >> 16);
            float ss = 0.f;
#pragma unroll
            for (int j = 0; j < 16; ++j) ss += v[j] * v[j];
            ss += __shfl_xor(ss, 1); ss += __shfl_xor(ss, 2); ss += __shfl_xor(ss, 4);
            const float rs = __builtin_amdgcn_rsqf(ss * (1.0f / 128.0f) + EPS);
            u32x4 o0, o1;
#define PP(i) pk2(v[i] * rs * gkn[i], v[i + 1] * rs * gkn[i + 1])
            o0.x = PP(0); o0.y = PP(2); o0.z = PP(4); o0.w = PP(6); o1.x = PP(8); o1.y = PP(10); o1.z = PP(12); o1.w = PP(14);
#undef PP
            *(u32x4*)p = o0; *(u32x4*)(p + 8) = o1;
        }
    }
}

template <int DK, int K1W, int DV, int DVH, bool BIAS>
__device__ __forceinline__ void attn_simple(const bf16_t* Q, int qp, const bf16_t* K1, int k1p, const bf16_t* K2, int k2p, const bf16_t* V, int vp, bf16_t* O, int op,
                                            const float* F2, int nheads, int qhs, int khs, int vhs, int ohs, int gw, int ngw, int lane) {
    const int nitems = BATCH * nheads * (SEQ / 64);
    for (int it = gw; it < nitems; it += ngw) {
        const int g = (SEQ / 64 - 1) - (it % (SEQ / 64)), bh = it / (SEQ / 64), b = bh / nheads, h = bh % nheads;
        const size_t rb = (size_t)b * SEQ; const int q = 64 * g + lane;
        const bf16_t* qrow = Q + (rb + q) * qp + h * qhs;
        const bf16_t* k1 = K1 + rb * k1p + h * khs; const bf16_t* k2 = K2 ? K2 + rb * k2p : nullptr; const bf16_t* vv = V + rb * vp + h * vhs;
        const float* f2 = BIAS ? F2 + ((size_t)b * nheads + h) * SEQ : nullptr;
        for (int vh = 0; vh < DV; vh += DVH) {
        float acc[DVH];
#pragma unroll
        for (int c = 0; c < DVH; ++c) acc[c] = 0.f;
        float m = -1e30f, l = 0.f;
        const int jmax = 64 * g + 63;
        for (int j = 0; j <= jmax; ++j) {
            float s = 0.f;
            const bf16_t* kr1 = k1 + (size_t)j * k1p;
            const bf16_t* qv = qrow; asm volatile("" : "+v"(qv));
#pragma unroll 4
            for (int d = 0; d < K1W; d += 8) { const u32x4 kk = *(const u32x4*)(kr1 + d), qq = *(const u32x4*)(qv + d);
                s += bf2f(kk.x & 0xffffu) * bf2f(qq.x & 0xffffu) + bf2f(kk.x >> 16) * bf2f(qq.x >> 16) + bf2f(kk.y & 0xffffu) * bf2f(qq.y & 0xffffu) + bf2f(kk.y >> 16) * bf2f(qq.y >> 16)
                   + bf2f(kk.z & 0xffffu) * bf2f(qq.z & 0xffffu) + bf2f(kk.z >> 16) * bf2f(qq.z >> 16) + bf2f(kk.w & 0xffffu) * bf2f(qq.w & 0xffffu) + bf2f(kk.w >> 16) * bf2f(qq.w >> 16); }
            if (DK > K1W) { const bf16_t* kr2 = k2 + (size_t)j * k2p;
#pragma unroll 4
                for (int d = 0; d < DK - K1W; d += 8) { const u32x4 kk = *(const u32x4*)(kr2 + d), qq = *(const u32x4*)(qv + K1W + d);
                    s += bf2f(kk.x & 0xffffu) * bf2f(qq.x & 0xffffu) + bf2f(kk.x >> 16) * bf2f(qq.x >> 16) + bf2f(kk.y & 0xffffu) * bf2f(qq.y & 0xffffu) + bf2f(kk.y >> 16) * bf2f(qq.y >> 16)
                       + bf2f(kk.z & 0xffffu) * bf2f(qq.z & 0xffffu) + bf2f(kk.z >> 16) * bf2f(qq.z >> 16) + bf2f(kk.w & 0xffffu) * bf2f(qq.w & 0xffffu) + bf2f(kk.w >> 16) * bf2f(qq.w >> 16); } }
            if (BIAS) s -= f2[j];
            const bool ok = (j <= q);
            const float mn = ok ? fmaxf(m, s) : m;
            const float alpha = exp2f(m - mn); const float pr = ok ? exp2f(s - mn) : 0.f;
            m = mn; l = l * alpha + pr;
            const bf16_t* vr = vv + (size_t)j * vp + vh;
#pragma unroll
            for (int c = 0; c < DVH; c += 8) { const u32x4 w = *(const u32x4*)(vr + c);
                acc[c + 0] = acc[c + 0] * alpha + pr * bf2f(w.x & 0xffffu); acc[c + 1] = acc[c + 1] * alpha + pr * bf2f(w.x >> 16);
                acc[c + 2] = acc[c + 2] * alpha + pr * bf2f(w.y & 0xffffu); acc[c + 3] = acc[c + 3] * alpha + pr * bf2f(w.y >> 16);
                acc[c + 4] = acc[c + 4] * alpha + pr * bf2f(w.z & 0xffffu); acc[c + 5] = acc[c + 5] * alpha + pr * bf2f(w.z >> 16);
                acc[c + 6] = acc[c + 6] * alpha + pr * bf2f(w.w & 0xffffu); acc[c + 7] = acc[c + 7] * alpha + pr * bf2f(w.w >> 16); }
        }
        const float il = 1.0f / l; bf16_t* orow = O + (rb + q) * op + h * ohs + vh;
#pragma unroll
        for (int c = 0; c < DVH; c += 8) { u32x4 w; w.x = pk2(acc[c] * il, acc[c + 1] * il); w.y = pk2(acc[c + 2] * il, acc[c + 3] * il); w.z = pk2(acc[c + 4] * il, acc[c + 5] * il); w.w = pk2(acc[c + 6] * il, acc[c + 7] * il);
            *(u32x4*)(orow + c) = w; }
        }
    }
}


typedef float f32x16 __attribute__((ext_vector_type(16)));
typedef short s16x4 __attribute__((ext_vector_type(4)));
__device__ __forceinline__ s16x4 vtr(const LAS char* p) { return __builtin_bit_cast(s16x4, __builtin_amdgcn_ds_read_tr16_b64_v4i16((LAS s16x4*)p)); }
__device__ __forceinline__ f32x16 mfma32(bf16x8 a, bf16x8 b, f32x16 c) { return __builtin_amdgcn_mfma_f32_32x32x16_bf16(a, b, c, 0, 0, 0); }
__device__ __forceinline__ unsigned cvtpk(float lo, float hi) { unsigned r; asm("v_cvt_pk_bf16_f32 %0, %1, %2" : "=v"(r) : "v"(lo), "v"(hi)); return r; }
__device__ __forceinline__ int crow(int r, int hi) { return (r & 3) + 8 * (r >> 2) + 4 * hi; }

template <bool MLA> struct AttnCfg {
    static constexpr int DK = MLA ? 192 : 64, DV = MLA ? 128 : 64;
    static constexpr int QBW = MLA ? 1 : 2, UR = 256 * QBW;
    static constexpr int KT = MLA ? 64 : 128, NSUB = KT / 64, NSTG = 3;
    static constexpr int KS = DK * 2, VS = DV * 2;
    static constexpr int KBUF = KT * KS, VBUF = KT * VS, BBUF = MLA ? 0 : 1024, STAGE = KBUF + VBUF + BBUF;
    static constexpr int KCH = DK / 8, VCH = DV / 8;
    static constexpr int NKC = KT * KCH / NTHREADS, NVC = KT * VCH / NTHREADS;
    static constexpr int G = NKC + NVC + (MLA ? 0 : 1);
};
struct AttnPtrs { const bf16_t* Q; int qp; const bf16_t* K1; int k1p; const bf16_t* K2; int k2p; const bf16_t* V; int vp; unsigned char* O; int op; const float* F2; };
template <bool MLA, int VAR>
__device__ __forceinline__ void attn_unit(const AttnPtrs& P, int qb, char* lds_, const float MB) {
    typedef AttnCfg<MLA> C;
    const LAS char* lds = (const LAS char*)lds_;
    int tid = threadIdx.x; asm volatile("" : "+v"(tid));
    const int lane = tid & 63, wid = __builtin_amdgcn_readfirstlane(tid >> 6), r32 = lane & 31, hi = lane >> 5;
    const int q0 = qb * C::UR, qw0 = q0 + 32 * C::QBW * wid, NT = (q0 + C::UR) / C::KT;
    bf16x8 qf[C::QBW][C::DK / 16]; float cq[C::QBW];
#pragma unroll
    for (int qi = 0; qi < C::QBW; ++qi) { const bf16_t* qr = P.Q + (size_t)(qw0 + 32 * qi + r32) * P.qp + 8 * hi;
#pragma unroll
      for (int d0 = 0; d0 < C::DK / 16; ++d0) qf[qi][d0] = *(const bf16x8*)(qr + 16 * d0);
      cq[qi] = -MB; if (!MLA) cq[qi] += P.F2[qw0 + 32 * qi + r32]; }
#pragma unroll
    for (int qi = 0; qi < C::QBW; ++qi) {
#pragma unroll
        for (int d0 = 0; d0 < C::DK / 16; ++d0) asm volatile("" : "+v"(qf[qi][d0]));
        asm volatile("" : "+v"(cq[qi])); }
    int t0 = 0;
    if (!MLA) { const float fk = (lane < NT) ? P.F2[C::KT * lane + C::KT - 1] : 0.f; const float fq0 = P.F2[q0];
        const unsigned long long m = __ballot((lane < NT) && (fq0 - fk >= -160.0f)); t0 = __builtin_amdgcn_readfirstlane(m ? (int)__builtin_ctzll(m) : 0); }
    int koff[C::NKC], kstep[C::NKC], voff[C::NVC];
#pragma unroll
    for (int i = 0; i < C::NKC; ++i) { const int u = (wid + 8 * i) * 64 + lane, row = u / C::KCH, cp = u % C::KCH, c = cp ^ ((row >> 1) & 7);
        if (MLA && c >= 16) { koff[i] = (int)((const char*)P.K2 - (const char*)P.K1) + (row * P.k2p + (c - 16) * 8) * 2; kstep[i] = C::KT * P.k2p * 2; } else { koff[i] = (row * P.k1p + c * 8) * 2; kstep[i] = C::KT * P.k1p * 2; } }
#pragma unroll
    for (int i = 0; i < C::NVC; ++i) { const int u = (wid + 8 * i) * 64 + lane, row = u / C::VCH, cp = u % C::VCH, c = MLA ? (cp ^ ((row & 3) << 2)) : (cp ^ (((row >> 1) & 1) << 2));
        voff[i] = (row * P.vp + c * 8) * 2; }
    int vstep = C::KT * P.vp * 2;
    if (VAR == 8) {
#pragma unroll
        for (int i = 0; i < C::NKC; ++i) { koff[i] = ((wid + 8 * i) * 64 + lane) * 16; kstep[i] = C::STAGE; }
#pragma unroll
        for (int i = 0; i < C::NVC; ++i) voff[i] = C::KBUF + ((wid + 8 * i) * 64 + lane) * 16;
        vstep = C::STAGE; }
    int boff = lane * 16 + t0 * C::KT * 4;
    if (!MLA) {
#pragma unroll
        for (int i = 0; i < C::NKC; ++i) koff[i] += t0 * kstep[i];
#pragma unroll
        for (int i = 0; i < C::NVC; ++i) voff[i] += t0 * vstep; }
#define ATT_DMA(stg) do { \
        _Pragma("unroll") for (int i = 0; i < C::NKC; ++i) { __builtin_amdgcn_global_load_lds((const unsigned*)((const char*)P.K1 + koff[i]), (LAS unsigned*)(lds_ + (stg) * C::STAGE + (wid + 8 * i) * 1024), 16, 0, 0); koff[i] += kstep[i]; } \
        _Pragma("unroll") for (int i = 0; i < C::NVC; ++i) { __builtin_amdgcn_global_load_lds((const unsigned*)((const char*)P.V + voff[i]), (LAS unsigned*)(lds_ + (stg) * C::STAGE + C::KBUF + (wid + 8 * i) * 1024), 16, 0, 0); voff[i] += vstep; } \
        if (!MLA) { __builtin_amdgcn_global_load_lds((const unsigned*)((const char*)P.F2 + boff), (LAS unsigned*)(lds_ + (stg) * C::STAGE + C::KBUF + C::VBUF), 16, 0, 0); boff += C::KT * 4; } } while (0)
    ATT_DMA(0); ATT_DMA(1);
    f32x16 oT[C::QBW][C::DV / 32];
#pragma unroll
    for (int qi = 0; qi < C::QBW; ++qi)
#pragma unroll
        for (int d0 = 0; d0 < C::DV / 32; ++d0)
#pragma unroll
            for (int r = 0; r < 16; ++r) oT[qi][d0][r] = 0.f;
    float l_run[C::QBW];
#pragma unroll
    for (int qi = 0; qi < C::QBW; ++qi) l_run[qi] = 0.f;
    int kb4[4];
#pragma unroll
    for (int j = 0; j < 4; ++j) kb4[j] = r32 * C::KS + (((2 * j + hi) ^ ((r32 >> 1) & 7)) * 16);
    const int vq = (lane & 15) >> 2;
    int vb4[C::DV / 32];
#pragma unroll
    for (int d0 = 0; d0 < C::DV / 32; ++d0) vb4[d0] = C::KBUF + (4 * hi + vq) * C::VS + ((MLA ? (d0 ^ vq) : (d0 ^ (vq >> 1))) * 64) + ((lane >> 4) & 1) * 32 + (lane & 3) * 8;
    int stg = 0;
    for (int t = t0; t < NT; ++t) {
        if (t + 1 < NT) asm volatile("s_waitcnt vmcnt(%0)" :: "n"(C::G) : "memory"); else asm volatile("s_waitcnt vmcnt(0)" ::: "memory");
        asm volatile("s_waitcnt lgkmcnt(0)" ::: "memory");
        if (VAR != 3) __builtin_amdgcn_s_barrier();
        if (VAR == 0 || VAR == 2 || VAR == 7 || VAR == 8) if (t + 2 < NT) { const int s2 = stg >= 1 ? stg - 1 : 2; ATT_DMA(s2); }
        const LAS char* sbase = lds + stg * C::STAGE;
#pragma unroll
        for (int sub = 0; sub < C::NSUB; ++sub) {
            const int kb = t * C::KT + 64 * sub;
            if (kb > qw0 + 32 * C::QBW - 1) continue;
            if (VAR == 2) continue;
            const LAS char* sk = sbase + sub * 64 * C::KS; const LAS char* sv = sbase + sub * 64 * C::VS;
            f32x16 p[C::QBW][2];
            if (MLA) {
#pragma unroll
                for (int qi = 0; qi < C::QBW; ++qi)
#pragma unroll
                    for (int r = 0; r < 16; ++r) { p[qi][0][r] = cq[qi]; p[qi][1][r] = cq[qi]; }
            } else {
#pragma unroll
                for (int g = 0; g < 4; ++g) { const f32x4 b0 = *(const LAS f32x4*)(sbase + C::KBUF + C::VBUF + (64 * sub + 8 * g + 4 * hi) * 4), b1 = *(const LAS f32x4*)(sbase + C::KBUF + C::VBUF + (64 * sub + 32 + 8 * g + 4 * hi) * 4);
#pragma unroll
                    for (int qi = 0; qi < C::QBW; ++qi)
#pragma unroll
                        for (int j = 0; j < 4; ++j) { p[qi][0][4 * g + j] = cq[qi] - b0[j]; p[qi][1][4 * g + j] = cq[qi] - b1[j]; } }
            }
            if (VAR != 5) {
                constexpr int ND = C::DK / 16, PFK = MLA ? 3 : 1;
                bf16x8 kf[PFK + 1][2];
                unsigned kaddr[4];
#pragma unroll
                for (int j = 0; j < 4; ++j) kaddr[j] = (unsigned)(uintptr_t)(sk + (VAR == 6 ? 0 : kb4[j]));
#define KRD2(slot, d) do { asm volatile("ds_read_b128 %0, %1 offset:%2" : "=v"(kf[slot][0]) : "v"(kaddr[(d) & 3]), "n"(((d) >> 2) * 128)); \
                           asm volatile("ds_read_b128 %0, %1 offset:%2" : "=v"(kf[slot][1]) : "v"(kaddr[(d) & 3]), "n"(((d) >> 2) * 128 + 32 * C::KS)); } while (0)
                asm volatile("s_waitcnt lgkmcnt(0)" ::: "memory");
#pragma unroll
                for (int d0 = 0; d0 < PFK; ++d0) KRD2(d0, d0);
#pragma unroll
                for (int d0 = 0; d0 < ND; ++d0) {
                    if (d0 + PFK < ND) { KRD2((d0 + PFK) % (PFK + 1), d0 + PFK); asm volatile("s_waitcnt lgkmcnt(%0)" :: "n"(2 * PFK) : "memory"); }
                    else asm volatile("s_waitcnt lgkmcnt(%0)" :: "n"(2 * (ND - 1 - d0)) : "memory");
                    __builtin_amdgcn_sched_barrier(0);
#pragma unroll
                    for (int qi = 0; qi < C::QBW; ++qi) { p[qi][0] = mfma32(kf[d0 % (PFK + 1)][0], qf[qi][d0], p[qi][0]); p[qi][1] = mfma32(kf[d0 % (PFK + 1)][1], qf[qi][d0], p[qi][1]); }
                    __builtin_amdgcn_sched_barrier(0);
                }
#undef KRD2
            }
            bf16x8 pb[C::QBW][4];
#pragma unroll
            for (int qi = 0; qi < C::QBW; ++qi) {
                const int qwi = qw0 + 32 * qi;
                if (kb + 63 > qwi) {
                    const int dq = qwi + r32 - kb - 4 * hi;
#pragma unroll
                    for (int r = 0; r < 16; ++r) { const int c = (r & 3) + 8 * (r >> 2); if (c > dq) p[qi][0][r] = -__builtin_inff(); if (c + 32 > dq) p[qi][1][r] = -__builtin_inff(); }
                }
                float ps = 0.f;
#pragma unroll
                for (int r = 0; r < 16; ++r) { p[qi][0][r] = __builtin_amdgcn_exp2f(p[qi][0][r]); p[qi][1][r] = __builtin_amdgcn_exp2f(p[qi][1][r]); ps += p[qi][0][r] + p[qi][1][r]; }
                l_run[qi] += ps;
#pragma unroll
                for (int s = 0; s < 4; ++s) { u32x4 w; const f32x16& pp = p[qi][s >> 1]; const int o = 8 * (s & 1);
                    w.x = cvtpk(pp[o + 0], pp[o + 1]); w.y = cvtpk(pp[o + 2], pp[o + 3]); w.z = cvtpk(pp[o + 4], pp[o + 5]); w.w = cvtpk(pp[o + 6], pp[o + 7]);
                    pb[qi][s] = __builtin_bit_cast(bf16x8, w); }
            }
            if (VAR != 4) {
                constexpr int NM = (C::DV / 32) * 4, PFV = MLA ? 3 : 2;
                s16x4 vl[PFV + 1], vh[PFV + 1];
#define VTR2(slot, n) do { asm volatile("ds_read_b64_tr_b16 %0, %1 offset:%2" : "=v"(vl[slot]) : "v"(vaddr[(n) >> 2]), "n"(((n) & 3) * 16 * C::VS)); \
                           asm volatile("ds_read_b64_tr_b16 %0, %1 offset:%2" : "=v"(vh[slot]) : "v"(vaddr[(n) >> 2]), "n"(((n) & 3) * 16 * C::VS + 8 * C::VS)); } while (0)
                unsigned vaddr[C::DV / 32];
#pragma unroll
                for (int d0 = 0; d0 < C::DV / 32; ++d0) vaddr[d0] = (unsigned)(uintptr_t)(sv + (VAR == 6 ? C::KBUF : vb4[d0]));
                asm volatile("s_waitcnt lgkmcnt(0)" ::: "memory");
#pragma unroll
                for (int i = 0; i < PFV; ++i) VTR2(i, i);
#pragma unroll
                for (int i = 0; i < NM; ++i) {
                    if (i + PFV < NM) { VTR2((i + PFV) % (PFV + 1), i + PFV); asm volatile("s_waitcnt lgkmcnt(%0)" :: "n"(2 * PFV) : "memory"); }
                    else asm volatile("s_waitcnt lgkmcnt(%0)" :: "n"(2 * (NM - 1 - i)) : "memory");
                    __builtin_amdgcn_sched_barrier(0);
                    const s16x4 lo = vl[i % (PFV + 1)], hh = vh[i % (PFV + 1)];
                    const bf16x8 vf = (bf16x8){lo[0], lo[1], lo[2], lo[3], hh[0], hh[1], hh[2], hh[3]};
#pragma unroll
                    for (int qi = 0; qi < C::QBW; ++qi) oT[qi][i >> 2] = mfma32(vf, pb[qi][i & 3], oT[qi][i >> 2]);
                    __builtin_amdgcn_sched_barrier(0);
                }
#undef VTR2
            }
        }
        stg = stg == 2 ? 0 : stg + 1;
    }
    asm volatile("s_waitcnt lgkmcnt(0)" ::: "memory");
    __builtin_amdgcn_s_barrier();
#pragma unroll
    for (int qi = 0; qi < C::QBW; ++qi) {
        float l = l_run[qi]; l += __shfl_xor(l, 32);
        const float il = (F8_P4 ? F8_SX : 1.0f) / l; unsigned char* orow = P.O + (size_t)(qw0 + 32 * qi + r32) * P.op + (F8_P4 ? 4 : 8) * hi;
#pragma unroll
        for (int d0 = 0; d0 < C::DV / 32; ++d0)
#pragma unroll
            for (int g = 0; g < 4; ++g) { const f32x4 ov = (f32x4){oT[qi][d0][4 * g] * il, oT[qi][d0][4 * g + 1] * il, oT[qi][d0][4 * g + 2] * il, oT[qi][d0][4 * g + 3] * il};
                if (F8_P4) *(unsigned*)(orow + 32 * d0 + 8 * g) = pk4_fp8(ov); else *(u32x2*)(orow + 64 * d0 + 16 * g) = pk4(ov); }
    }
#undef ATT_DMA
}
typedef int v4i_t __attribute__((ext_vector_type(4)));
template <bool MLA> struct AttnCfg8 {
    static constexpr int DK = MLA ? 192 : 64, DV = MLA ? 128 : 64, NDC = DK / 64;
    static constexpr int QBW = MLA ? 1 : 2, UR = 256 * QBW;
    static constexpr int KT = MLA ? (MLA_KT128 ? 128 : 64) : (FOX_KT256 ? 256 : 128), NSUB = KT / 64, NSTG = ((MLA && MLA_KT128) || (!MLA && FOX_KT256)) ? 2 : 3;
    static constexpr int KS = DK, VS = DV * 2;
    static constexpr int KBUF = KT * KS, VBUF = KT * VS, BBUF = MLA ? 0 : (FOX_BIAS_MFMA ? KT * 16 : 1024), NBP = BBUF / 1024, STAGE = KBUF + VBUF + BBUF;
    static constexpr int KCH = KS / 16, VCH = DV / 8;
    static constexpr int NKP = KBUF / 1024, NKW = (NKP + 7) / 8;
    static constexpr int NVC = KT * VCH / NTHREADS;
};
struct AttnPtrs8 { const unsigned char* Q; int qp; const unsigned char* K1; int k1p; const unsigned char* K2; int k2p; const bf16_t* V; int vp; unsigned char* O; int op; const float* F2; const unsigned char* FR; };
template <bool MLA>
__device__ __forceinline__ void attn_unit8(const AttnPtrs8& P, int qb, char* lds_, const float MB, int* qctr = nullptr) {
    typedef AttnCfg8<MLA> C;
    const LAS char* lds = (const LAS char*)lds_;
    int tid = threadIdx.x; asm volatile("" : "+v"(tid));
    const int lane = tid & 63, wid = __builtin_amdgcn_readfirstlane(tid >> 6), r32 = lane & 31, hi = lane >> 5;
    const int q0 = qb * C::UR, qw0 = q0 + 32 * C::QBW * wid, NT = (q0 + C::UR) / C::KT;
    v8i qf[C::QBW][C::NDC]; float cq[C::QBW];
#pragma unroll
    for (int qi = 0; qi < C::QBW; ++qi) { const unsigned char* qr = P.Q + (size_t)(qw0 + 32 * qi + r32) * P.qp + 32 * hi;
#pragma unroll
      for (int m = 0; m < C::NDC; ++m) { const v4i_t a = *(const v4i_t*)(qr + 64 * m), b = *(const v4i_t*)(qr + 64 * m + 16); qf[qi][m] = __builtin_shufflevector(a, b, 0, 1, 2, 3, 4, 5, 6, 7); }
      cq[qi] = -MB; if (!MLA) cq[qi] += P.F2[qw0 + 32 * qi + r32]; }
    int t0 = 0;
    int s0w = 0;
    if (!MLA) {
        const float TS = 2.0f * MB + 40.0f;
        const float fk = P.F2[C::KT * min(lane, NT - 1) + C::KT - 1]; const float fq0 = P.F2[q0];
        const unsigned long long m = __ballot((lane < NT) && (fq0 - fk >= -TS)); t0 = __builtin_amdgcn_readfirstlane(m ? (int)__builtin_ctzll(m) : 0);
        const int ns = qw0 / 64 + 1; const float fqw = P.F2[qw0];
        const float f0 = P.F2[64 * min(lane, ns - 1) + 63], f1 = P.F2[64 * min(lane + 64, ns - 1) + 63];
        const unsigned long long m0 = __ballot((lane < ns) && (fqw - f0 >= -TS)), m1 = __ballot((lane + 64 < ns) && (fqw - f1 >= -TS));
        s0w = __builtin_amdgcn_readfirstlane(m0 ? (int)__builtin_ctzll(m0) : (m1 ? 64 + (int)__builtin_ctzll(m1) : ns - 1)); }
    const bool two_k = MLA && !MLA_KT128 && wid < 4;
    constexpr int NKW = (MLA && !MLA_KT128) ? 2 : C::NKW;
    int koff[NKW], kstep[NKW], voff[C::NVC];
#pragma unroll
    for (int i = 0; i < NKW; ++i) { const int u = (wid + 8 * i) * 64 + lane, row = u / C::KCH, cp = u % C::KCH, c = cp ^ ((row >> 2) & 3);
        if (MLA && c >= 8) { koff[i] = (int)(P.K2 - P.K1) + row * P.k2p + (c - 8) * 16; kstep[i] = C::KT * P.k2p; } else { koff[i] = row * P.k1p + c * 16; kstep[i] = C::KT * P.k1p; } }
#pragma unroll
    for (int i = 0; i < C::NVC; ++i) { const int u = (wid + 8 * i) * 64 + lane, row = u / C::VCH, cp = u % C::VCH, c = MLA ? (cp ^ ((row & 3) << 2)) : (cp ^ (((row >> 1) & 1) << 2));
        voff[i] = (row * P.vp + c * 8) * 2; }
    const int vstep = C::KT * P.vp * 2;
    const int bpc = (!MLA && FOX_BIAS_MFMA) ? (wid & (C::NBP - 1)) * 1024 : 0;
    int boff = (!MLA && FOX_BIAS_MFMA) ? lane * 16 + bpc + t0 * C::KT * 16 : lane * 16 + t0 * C::KT * 4;
    if (!MLA) {
#pragma unroll
        for (int i = 0; i < NKW; ++i) koff[i] += t0 * kstep[i];
#pragma unroll
        for (int i = 0; i < C::NVC; ++i) voff[i] += t0 * vstep; }
#define ATT_DMA(stg) do { \
        __builtin_amdgcn_global_load_lds((const unsigned*)(P.K1 + koff[0]), (LAS unsigned*)(lds_ + (stg) * C::STAGE + wid * 1024), 16, 0, 0); koff[0] += kstep[0]; \
        if (C::NSTG == 2) { _Pragma("unroll") for (int i = 1; i < NKW; ++i) { __builtin_amdgcn_global_load_lds((const unsigned*)(P.K1 + koff[i]), (LAS unsigned*)(lds_ + (stg) * C::STAGE + (wid + 8 * i) * 1024), 16, 0, 0); koff[i] += kstep[i]; } } \
        else if (two_k) { __builtin_amdgcn_global_load_lds((const unsigned*)(P.K1 + koff[1]), (LAS unsigned*)(lds_ + (stg) * C::STAGE + (wid + 8) * 1024), 16, 0, 0); koff[1] += kstep[1]; } \
        _Pragma("unroll") for (int i = 0; i < C::NVC; ++i) { __builtin_amdgcn_global_load_lds((const unsigned*)((const char*)P.V + voff[i]), (LAS unsigned*)(lds_ + (stg) * C::STAGE + C::KBUF + (wid + 8 * i) * 1024), 16, 0, 0); voff[i] += vstep; } \
        if (!MLA) { if (FOX_BIAS_MFMA) { __builtin_amdgcn_global_load_lds((const unsigned*)(P.FR + boff), (LAS unsigned*)(lds_ + (stg) * C::STAGE + C::KBUF + C::VBUF + bpc), 16, 0, 0); boff += C::KT * 16; } \
                    else { __builtin_amdgcn_global_load_lds((const unsigned*)((const char*)P.F2 + boff), (LAS unsigned*)(lds_ + (stg) * C::STAGE + C::KBUF + C::VBUF), 16, 0, 0); boff += C::KT * 4; } } } while (0)
    ATT_DMA(0); if (C::NSTG == 3) ATT_DMA(1);
    bf16x8 bq[C::QBW];
    if (!MLA && FOX_BIAS_MFMA) {
#pragma unroll
        for (int qi = 0; qi < C::QBW; ++qi) { const float x = cq[qi]; const unsigned c1 = f2bf(x); const float r1 = x - bf2f(c1); const unsigned c2 = f2bf(r1); const unsigned c3 = f2bf(r1 - bf2f(c2));
            u32x4 w = (u32x4){c1 | (c2 << 16), c3 | 0xbf800000u, 0xbf80bf80u, 0u}; if (hi) w = (u32x4){0u, 0u, 0u, 0u};
            bq[qi] = __builtin_bit_cast(bf16x8, w); asm volatile("" : "+v"(bq[qi])); } }
#pragma unroll
    for (int qi = 0; qi < C::QBW; ++qi) {
#pragma unroll
        for (int m = 0; m < C::NDC; ++m) asm volatile("" : "+v"(qf[qi][m]));
        asm volatile("" : "+v"(cq[qi])); }
    f32x16 oT[C::QBW][C::DV / 32];
#pragma unroll
    for (int qi = 0; qi < C::QBW; ++qi)
#pragma unroll
        for (int d0 = 0; d0 < C::DV / 32; ++d0)
#pragma unroll
            for (int r = 0; r < 16; ++r) oT[qi][d0][r] = 0.f;
    float l_run[C::QBW];
#pragma unroll
    for (int qi = 0; qi < C::QBW; ++qi) l_run[qi] = 0.f;
    int kb2[2];
#pragma unroll
    for (int j = 0; j < 2; ++j) kb2[j] = r32 * C::KS + (((2 * hi + j) ^ ((r32 >> 2) & 3)) * 16);
    const int vq = (lane & 15) >> 2;
    int vb4[C::DV / 32];
#pragma unroll
    for (int d0 = 0; d0 < C::DV / 32; ++d0) vb4[d0] = C::KBUF + (4 * hi + vq) * C::VS + ((MLA ? (d0 ^ vq) : (d0 ^ (vq >> 1))) * 64) + ((lane >> 4) & 1) * 32 + (lane & 3) * 8;
    const int sclK = 0x7b7b7b7b, sclQ = 0x79797979;
    int stg = 0;
    for (int t = t0; t < NT; ++t) {
        if (C::NSTG == 2) asm volatile("s_waitcnt vmcnt(0)" ::: "memory");
        else if (t + 1 < NT) { if (MLA) { if (two_k) asm volatile("s_waitcnt vmcnt(4)" ::: "memory"); else asm volatile("s_waitcnt vmcnt(3)" ::: "memory"); } else asm volatile("s_waitcnt vmcnt(4)" ::: "memory"); }
        else asm volatile("s_waitcnt vmcnt(0)" ::: "memory");
        asm volatile("s_waitcnt lgkmcnt(0)" ::: "memory");
        __builtin_amdgcn_s_barrier();
        if (C::NSTG == 2) { if (t + 1 < NT) { const int s1 = stg ^ 1; ATT_DMA(s1); } }
        else if (t + 2 < NT) { const int s2 = stg >= 1 ? stg - 1 : 2; ATT_DMA(s2); }
        const LAS char* sbase = lds + stg * C::STAGE;
#pragma unroll
        for (int sub = 0; sub < C::NSUB; ++sub) {
            const int kb = t * C::KT + 64 * sub;
            if (kb > qw0 + 32 * C::QBW - 1) continue;
            if (!MLA && t * C::NSUB + sub < s0w) continue;
            const LAS char* sk = sbase + sub * 64 * C::KS; const LAS char* sv = sbase + sub * 64 * C::VS;
            f32x16 p[C::QBW][2];
            if (MLA) {
#pragma unroll
                for (int qi = 0; qi < C::QBW; ++qi)
#pragma unroll
                    for (int r = 0; r < 16; ++r) { p[qi][0][r] = cq[qi]; p[qi][1][r] = cq[qi]; }
            } else if (FOX_BIAS_MFMA) {
                f32x16 z16;
#pragma unroll
                for (int r = 0; r < 16; ++r) z16[r] = 0.f;
#pragma unroll
                for (int kh = 0; kh < 2; ++kh) { const bf16x8 ar = *(const LAS bf16x8*)(sbase + C::KBUF + C::VBUF + (64 * sub + 32 * kh + r32) * 16);
#pragma unroll
                    for (int qi = 0; qi < C::QBW; ++qi) p[qi][kh] = mfma32(ar, bq[qi], z16); }
            } else {
#pragma unroll
                for (int g = 0; g < 4; ++g) { const f32x4 b0 = *(const LAS f32x4*)(sbase + C::KBUF + C::VBUF + (64 * sub + 8 * g + 4 * hi) * 4), b1 = *(const LAS f32x4*)(sbase + C::KBUF + C::VBUF + (64 * sub + 32 + 8 * g + 4 * hi) * 4);
#pragma unroll
                    for (int qi = 0; qi < C::QBW; ++qi)
#pragma unroll
                        for (int j = 0; j < 4; ++j) { p[qi][0][4 * g + j] = cq[qi] - b0[j]; p[qi][1][4 * g + j] = cq[qi] - b1[j]; } }
            }
            {
                v8i kop[C::NDC][2];
#pragma unroll
                for (int m = 0; m < C::NDC; ++m)
#pragma unroll
                    for (int kh = 0; kh < 2; ++kh) { const LAS char* kp = sk + kh * 32 * C::KS + m * 64;
                        const v4i_t a = *(const LAS v4i_t*)(kp + kb2[0]), b = *(const LAS v4i_t*)(kp + kb2[1]); kop[m][kh] = __builtin_shufflevector(a, b, 0, 1, 2, 3, 4, 5, 6, 7); }
#pragma unroll
                for (int qi = 0; qi < C::QBW; ++qi) asm volatile("s_nop 7" : "+v"(p[qi][0]), "+v"(p[qi][1]));
#pragma unroll
                for (int m = 0; m < C::NDC; ++m)
#pragma unroll
                    for (int kh = 0; kh < 2; ++kh)
#pragma unroll
                        for (int qi = 0; qi < C::QBW; ++qi)
                            asm volatile("v_mfma_scale_f32_32x32x64_f8f6f4 %0, %1, %2, %0, %3, %4 op_sel_hi:[0,0,0]" : "+v"(p[qi][kh]) : "v"(kop[m][kh]), "v"(qf[qi][m]), "v"(sclK), "v"(sclQ));
#pragma unroll
                for (int qi = 0; qi < C::QBW; ++qi) asm volatile("s_nop 15\n\ts_nop 7" : "+v"(p[qi][0]), "+v"(p[qi][1]));
            }
            bf16x8 pb[C::QBW][4];
#pragma unroll
            for (int qi = 0; qi < C::QBW; ++qi) {
                const int qwi = qw0 + 32 * qi;
                if (kb + 63 > qwi) {
                    const int dq = qwi + r32 - kb - 4 * hi;
#pragma unroll
                    for (int r = 0; r < 16; ++r) { const int c = (r & 3) + 8 * (r >> 2); if (c > dq) p[qi][0][r] = -__builtin_inff(); if (c + 32 > dq) p[qi][1][r] = -__builtin_inff(); }
                }
                float ps = 0.f;
#pragma unroll
                for (int r = 0; r < 16; ++r) { p[qi][0][r] = __builtin_amdgcn_exp2f(p[qi][0][r]); p[qi][1][r] = __builtin_amdgcn_exp2f(p[qi][1][r]); ps += p[qi][0][r] + p[qi][1][r]; }
                l_run[qi] += ps;
#pragma unroll
                for (int s = 0; s < 4; ++s) { u32x4 w; const f32x16& pp = p[qi][s >> 1]; const int o = 8 * (s & 1);
                    w.x = cvtpk(pp[o + 0], pp[o + 1]); w.y = cvtpk(pp[o + 2], pp[o + 3]); w.z = cvtpk(pp[o + 4], pp[o + 5]); w.w = cvtpk(pp[o + 6], pp[o + 7]);
                    pb[qi][s] = __builtin_bit_cast(bf16x8, w); }
            }
            {
                constexpr int NM = (C::DV / 32) * 4, PFV = MLA ? 3 : 2;
                s16x4 vl[PFV + 1], vh[PFV + 1];
#define VTR2(slot, n) do { asm volatile("ds_read_b64_tr_b16 %0, %1 offset:%2" : "=v"(vl[slot]) : "v"(vaddr[(n) >> 2]), "n"(((n) & 3) * 16 * C::VS)); \
                           asm volatile("ds_read_b64_tr_b16 %0, %1 offset:%2" : "=v"(vh[slot]) : "v"(vaddr[(n) >> 2]), "n"(((n) & 3) * 16 * C::VS + 8 * C::VS)); } while (0)
                unsigned vaddr[C::DV / 32];
#pragma unroll
                for (int d0 = 0; d0 < C::DV / 32; ++d0) vaddr[d0] = (unsigned)(uintptr_t)(sv + vb4[d0]);
                asm volatile("s_waitcnt lgkmcnt(0)" ::: "memory");
#pragma unroll
                for (int i = 0; i < PFV; ++i) VTR2(i, i);
#pragma unroll
                for (int i = 0; i < NM; ++i) {
                    if (i + PFV < NM) { VTR2((i + PFV) % (PFV + 1), i + PFV); asm volatile("s_waitcnt lgkmcnt(%0)" :: "n"(2 * PFV) : "memory"); }
                    else asm volatile("s_waitcnt lgkmcnt(%0)" :: "n"(2 * (NM - 1 - i)) : "memory");
                    __builtin_amdgcn_sched_barrier(0);
                    const s16x4 lo = vl[i % (PFV + 1)], hh = vh[i % (PFV + 1)];
                    const bf16x8 vf = (bf16x8){lo[0], lo[1], lo[2], lo[3], hh[0], hh[1], hh[2], hh[3]};
#pragma unroll
                    for (int qi = 0; qi < C::QBW; ++qi) oT[qi][i >> 2] = mfma32(vf, pb[qi][i & 3], oT[qi][i >> 2]);
                    __builtin_amdgcn_sched_barrier(0);
                }
#undef VTR2
            }
        }
        stg = (C::NSTG == 2) ? (stg ^ 1) : (stg == 2 ? 0 : stg + 1);
    }
    asm volatile("s_waitcnt lgkmcnt(0)" ::: "memory");
    __builtin_amdgcn_s_barrier();
    int nxt_u = 0; if (!MLA && qctr) { if (tid == 0) nxt_u = atomicAdd(qctr, 1); }
#pragma unroll
    for (int qi = 0; qi < C::QBW; ++qi) {
        float l = l_run[qi]; l += __shfl_xor(l, 32);
        const float il = (F8_P4 ? F8_SX : 1.0f) / l; unsigned char* orow = P.O + (size_t)(qw0 + 32 * qi + r32) * P.op + (F8_P4 ? 4 : 8) * hi;
#pragma unroll
        for (int d0 = 0; d0 < C::DV / 32; ++d0)
#pragma unroll
            for (int g = 0; g < 4; ++g) { const f32x4 ov = (f32x4){oT[qi][d0][4 * g] * il, oT[qi][d0][4 * g + 1] * il, oT[qi][d0][4 * g + 2] * il, oT[qi][d0][4 * g + 3] * il};
                if (F8_P4) *(unsigned*)(orow + 32 * d0 + 8 * g) = pk4_fp8(ov); else *(u32x2*)(orow + 64 * d0 + 16 * g) = pk4(ov); }
    }
    if (!MLA && qctr) { if (tid == 0) ((volatile LAS int*)(LAS char*)lds)[(LDS_BYTES - 32) / 4] = nxt_u; }
#undef ATT_DMA
}
__device__ __forceinline__ void attn_unit_mla_pipe(const AttnPtrs& P, int qb, char* lds_, const float MB) {
    typedef AttnCfg<true> C;
    const LAS char* lds = (const LAS char*)lds_;
    int tid = threadIdx.x; asm volatile("" : "+v"(tid));
    const int lane = tid & 63, wid = __builtin_amdgcn_readfirstlane(tid >> 6), r32 = lane & 31, hi = lane >> 5;
    const int q0 = qb * 256, qw0 = q0 + 32 * wid, NT = (q0 + 256) / 64;
    bf16x8 qf[12];
    { const bf16_t* qr = P.Q + (size_t)(qw0 + r32) * P.qp + 8 * hi;
#pragma unroll
      for (int d0 = 0; d0 < 12; ++d0) qf[d0] = *(const bf16x8*)(qr + 16 * d0); }
#pragma unroll
    for (int d0 = 0; d0 < 12; ++d0) asm volatile("" : "+v"(qf[d0]));
    const float cq = -MB;
    int koff[C::NKC], kstep[C::NKC], voff[C::NVC];
#pragma unroll
    for (int i = 0; i < C::NKC; ++i) { const int u = (wid + 8 * i) * 64 + lane, row = u / C::KCH, cp = u % C::KCH, c = cp ^ ((row >> 1) & 7);
        if (c >= 16) { koff[i] = (int)((const char*)P.K2 - (const char*)P.K1) + (row * P.k2p + (c - 16) * 8) * 2; kstep[i] = 64 * P.k2p * 2; } else { koff[i] = (row * P.k1p + c * 8) * 2; kstep[i] = 64 * P.k1p * 2; } }
#pragma unroll
    for (int i = 0; i < C::NVC; ++i) { const int u = (wid + 8 * i) * 64 + lane, row = u / C::VCH, cp = u % C::VCH, c = cp ^ ((row & 3) << 2); voff[i] = (row * P.vp + c * 8) * 2; }
    const int vstep = 64 * P.vp * 2;
#define ATT_DMA(stg) do { \
        _Pragma("unroll") for (int i = 0; i < C::NKC; ++i) { __builtin_amdgcn_global_load_lds((const unsigned*)((const char*)P.K1 + koff[i]), (LAS unsigned*)(lds_ + (stg) * C::STAGE + (wid + 8 * i) * 1024), 16, 0, 0); koff[i] += kstep[i]; } \
        _Pragma("unroll") for (int i = 0; i < C::NVC; ++i) { __builtin_amdgcn_global_load_lds((const unsigned*)((const char*)P.V + voff[i]), (LAS unsigned*)(lds_ + (stg) * C::STAGE + C::KBUF + (wid + 8 * i) * 1024), 16, 0, 0); voff[i] += vstep; } } while (0)
    ATT_DMA(0); ATT_DMA(1);
    f32x16 oT[4];
#pragma unroll
    for (int d0 = 0; d0 < 4; ++d0)
#pragma unroll
        for (int r = 0; r < 16; ++r) oT[d0][r] = 0.f;
    float l_run = 0.f;
    int kb4[4];
#pragma unroll
    for (int j = 0; j < 4; ++j) kb4[j] = r32 * C::KS + (((2 * j + hi) ^ ((r32 >> 1) & 7)) * 16);
    const int vq = (lane & 15) >> 2;
    int vb4[4];
#pragma unroll
    for (int d0 = 0; d0 < 4; ++d0) vb4[d0] = C::KBUF + (4 * hi + vq) * C::VS + ((d0 ^ vq) * 64) + ((lane >> 4) & 1) * 32 + (lane & 3) * 8;
    constexpr int PFK = 3, PFV = 3, ND = 12, NM = 16;
    bf16x8 kf[PFK + 1]; unsigned kaddr[4]; s16x4 vl[PFV + 1], vh[PFV + 1]; unsigned vaddr[4]; bf16x8 pb[4];
#define KRD1(slot, d, half) asm volatile("ds_read_b128 %0, %1 offset:%2" : "=v"(kf[slot]) : "v"(kaddr[(d) & 3]), "n"(((d) >> 2) * 128 + (half) * 32 * C::KS))
#define VTR2(slot, n) do { asm volatile("ds_read_b64_tr_b16 %0, %1 offset:%2" : "=v"(vl[slot]) : "v"(vaddr[(n) >> 2]), "n"(((n) & 3) * 16 * C::VS)); \
                           asm volatile("ds_read_b64_tr_b16 %0, %1 offset:%2" : "=v"(vh[slot]) : "v"(vaddr[(n) >> 2]), "n"(((n) & 3) * 16 * C::VS + 8 * C::VS)); } while (0)
#define SMCH(T, c, pbb) do { const int e_ = 2 * (c); T[e_] = __builtin_amdgcn_exp2f(T[e_]); T[e_ + 1] = __builtin_amdgcn_exp2f(T[e_ + 1]); ps += T[e_] + T[e_ + 1]; \
        if (((c) & 3) == 3) { const int s_ = (c) >> 2; u32x4 w_; w_.x = cvtpk(T[8 * s_ + 0], T[8 * s_ + 1]); w_.y = cvtpk(T[8 * s_ + 2], T[8 * s_ + 3]); w_.z = cvtpk(T[8 * s_ + 4], T[8 * s_ + 5]); w_.w = cvtpk(T[8 * s_ + 6], T[8 * s_ + 7]); \
            pb[(pbb) + s_] = __builtin_bit_cast(bf16x8, w_); } } while (0)
#define QK_HALF(S, half, STG, DOSM, T, pbb) do { \
        _Pragma("unroll") for (int r = 0; r < 16; ++r) S[r] = cq; \
        const LAS char* sk_ = lds + (STG) * C::STAGE; \
        _Pragma("unroll") for (int j = 0; j < 4; ++j) kaddr[j] = (unsigned)(uintptr_t)(sk_ + kb4[j]); \
        asm volatile("s_waitcnt lgkmcnt(0)" ::: "memory"); \
        _Pragma("unroll") for (int d0 = 0; d0 < PFK; ++d0) KRD1(d0, d0, half); \
        _Pragma("unroll") for (int d0 = 0; d0 < ND; ++d0) { \
            if (d0 + PFK < ND) { KRD1((d0 + PFK) % (PFK + 1), d0 + PFK, half); asm volatile("s_waitcnt lgkmcnt(%0)" :: "n"(PFK) : "memory"); } \
            else asm volatile("s_waitcnt lgkmcnt(%0)" :: "n"(ND - 1 - d0) : "memory"); \
            __builtin_amdgcn_sched_barrier(0); \
            S = mfma32(kf[d0 % (PFK + 1)], qf[d0], S); \
            __builtin_amdgcn_sched_barrier(0); \
            if (DOSM) { if (d0 < 8) SMCH(T, d0, pbb); __builtin_amdgcn_sched_barrier(0); } \
        } } while (0)
#define MASKH(T, j, half) do { const int kb_ = 64 * (j) + 32 * (half); if (kb_ + 31 > qw0) { const int dq = qw0 + r32 - kb_ - 4 * hi; \
        _Pragma("unroll") for (int r = 0; r < 16; ++r) { const int c = (r & 3) + 8 * (r >> 2); if (c > dq) T[r] = -__builtin_inff(); } } } while (0)
#define PV_TILE(STG) do { const LAS char* sv_ = lds + (STG) * C::STAGE; \
        _Pragma("unroll") for (int d0 = 0; d0 < 4; ++d0) vaddr[d0] = (unsigned)(uintptr_t)(sv_ + vb4[d0]); \
        asm volatile("s_waitcnt lgkmcnt(0)" ::: "memory"); \
        _Pragma("unroll") for (int i = 0; i < PFV; ++i) VTR2(i, i); \
        _Pragma("unroll") for (int i = 0; i < NM; ++i) { \
            if (i + PFV < NM) { VTR2((i + PFV) % (PFV + 1), i + PFV); asm volatile("s_waitcnt lgkmcnt(%0)" :: "n"(2 * PFV) : "memory"); } \
            else asm volatile("s_waitcnt lgkmcnt(%0)" :: "n"(2 * (NM - 1 - i)) : "memory"); \
            __builtin_amdgcn_sched_barrier(0); \
            const s16x4 lo = vl[i % (PFV + 1)], hh = vh[i % (PFV + 1)]; \
            const bf16x8 vf = (bf16x8){lo[0], lo[1], lo[2], lo[3], hh[0], hh[1], hh[2], hh[3]}; \
            oT[i >> 2] = mfma32(vf, pb[i & 3], oT[i >> 2]); \
            __builtin_amdgcn_sched_barrier(0); \
        } } while (0)
    f32x16 S0, S1; float ps;
    int stg = 0;
    asm volatile("s_waitcnt vmcnt(%0)" :: "n"(C::G) : "memory"); asm volatile("s_waitcnt lgkmcnt(0)" ::: "memory");
    __builtin_amdgcn_s_barrier();
    ps = 0.f;
    QK_HALF(S0, 0, 0, false, S1, 0);
    MASKH(S0, 0, 0);
    QK_HALF(S1, 1, 0, true, S0, 0);
    l_run += ps;
    for (int j = 0; j < NT; ++j) {
        asm volatile("s_waitcnt vmcnt(0)" ::: "memory"); asm volatile("s_waitcnt lgkmcnt(0)" ::: "memory");
        __builtin_amdgcn_s_barrier();
        const int s1 = stg == 2 ? 0 : stg + 1;
        if (j + 2 < NT) { const int s2 = stg >= 1 ? stg - 1 : 2; ATT_DMA(s2); }
        MASKH(S1, j, 1);
        ps = 0.f;
        if (j + 1 < NT) { QK_HALF(S0, 0, s1, true, S1, 2); }
        else {
#pragma unroll
            for (int c = 0; c < 8; ++c) SMCH(S1, c, 2); }
        l_run += ps;
        PV_TILE(stg);
        if (j + 1 < NT) { MASKH(S0, j + 1, 0); ps = 0.f; QK_HALF(S1, 1, s1, true, S0, 0); l_run += ps; }
        stg = s1;
    }
    asm volatile("s_waitcnt lgkmcnt(0)" ::: "memory");
    __builtin_amdgcn_s_barrier();
    { float l = l_run; l += __shfl_xor(l, 32);
      const float il = (F8_P4 ? F8_SX : 1.0f) / l; unsigned char* orow = P.O + (size_t)(qw0 + r32) * P.op + (F8_P4 ? 4 : 8) * hi;
#pragma unroll
      for (int d0 = 0; d0 < 4; ++d0)
#pragma unroll
          for (int g = 0; g < 4; ++g) { const f32x4 ov = (f32x4){oT[d0][4 * g] * il, oT[d0][4 * g + 1] * il, oT[d0][4 * g + 2] * il, oT[d0][4 * g + 3] * il};
              if (F8_P4) *(unsigned*)(orow + 32 * d0 + 8 * g) = pk4_fp8(ov); else *(u32x2*)(orow + 64 * d0 + 16 * g) = pk4(ov); } }
#undef ATT_DMA
#undef KRD1
#undef VTR2
#undef SMCH
#undef QK_HALF
#undef MASKH
#undef PV_TILE
}
__device__ __forceinline__ void attn_unit_fox_pipe(const AttnPtrs& P, int qb, char* lds_, const float MB) {
    typedef AttnCfg<false> C;
    const LAS char* lds = (const LAS char*)lds_;
    int tid = threadIdx.x; asm volatile("" : "+v"(tid));
    const int lane = tid & 63, wid = __builtin_amdgcn_readfirstlane(tid >> 6), r32 = lane & 31, hi = lane >> 5;
    const int q0 = qb * C::UR, qw0 = q0 + 64 * wid, NT = (q0 + C::UR) / C::KT;
    bf16x8 qf[2][4]; float cq[2];
#pragma unroll
    for (int qi = 0; qi < 2; ++qi) { const bf16_t* qr = P.Q + (size_t)(qw0 + 32 * qi + r32) * P.qp + 8 * hi;
#pragma unroll
      for (int d0 = 0; d0 < 4; ++d0) qf[qi][d0] = *(const bf16x8*)(qr + 16 * d0);
      cq[qi] = -MB + P.F2[qw0 + 32 * qi + r32]; }
#pragma unroll
    for (int qi = 0; qi < 2; ++qi) {
#pragma unroll
        for (int d0 = 0; d0 < 4; ++d0) asm volatile("" : "+v"(qf[qi][d0]));
        asm volatile("" : "+v"(cq[qi])); }
    int t0 = 0;
    { const float fk = (lane < NT) ? P.F2[C::KT * lane + C::KT - 1] : 0.f; const float fq0 = P.F2[q0];
      const unsigned long long m = __ballot((lane < NT) && (fq0 - fk >= -160.0f)); t0 = __builtin_amdgcn_readfirstlane(m ? (int)__builtin_ctzll(m) : 0); }
    int koff[C::NKC], voff[C::NVC];
#pragma unroll
    for (int i = 0; i < C::NKC; ++i) { const int u = (wid + 8 * i) * 64 + lane, row = u / C::KCH, cp = u % C::KCH, c = cp ^ ((row >> 1) & 7); koff[i] = (row * P.k1p + c * 8) * 2; }
#pragma unroll
    for (int i = 0; i < C::NVC; ++i) { const int u = (wid + 8 * i) * 64 + lane, row = u / C::VCH, cp = u % C::VCH, c = cp ^ (((row >> 1) & 1) << 2); voff[i] = (row * P.vp + c * 8) * 2; }
    const int kstep = C::KT * P.k1p * 2, vstep = C::KT * P.vp * 2;
    int boff = lane * 16 + t0 * C::KT * 4;
#pragma unroll
    for (int i = 0; i < C::NKC; ++i) koff[i] += t0 * kstep;
#pragma unroll
    for (int i = 0; i < C::NVC; ++i) voff[i] += t0 * vstep;
#define ATT_DMA(stg) do { \
        _Pragma("unroll") for (int i = 0; i < C::NKC; ++i) { __builtin_amdgcn_global_load_lds((const unsigned*)((const char*)P.K1 + koff[i]), (LAS unsigned*)(lds_ + (stg) * C::STAGE + (wid + 8 * i) * 1024), 16, 0, 0); koff[i] += kstep; } \
        _Pragma("unroll") for (int i = 0; i < C::NVC; ++i) { __builtin_amdgcn_global_load_lds((const unsigned*)((const char*)P.V + voff[i]), (LAS unsigned*)(lds_ + (stg) * C::STAGE + C::KBUF + (wid + 8 * i) * 1024), 16, 0, 0); voff[i] += vstep; } \
        __builtin_amdgcn_global_load_lds((const unsigned*)((const char*)P.F2 + boff), (LAS unsigned*)(lds_ + (stg) * C::STAGE + C::KBUF + C::VBUF), 16, 0, 0); boff += C::KT * 4; } while (0)
    ATT_DMA(0); ATT_DMA(1);
    f32x16 oT[2][2];
#pragma unroll
    for (int qi = 0; qi < 2; ++qi)
#pragma unroll
        for (int d0 = 0; d0 < 2; ++d0)
#pragma unroll
            for (int r = 0; r < 16; ++r) oT[qi][d0][r] = 0.f;
    float l_run[2] = {0.f, 0.f};
    int kb4[4];
#pragma unroll
    for (int j = 0; j < 4; ++j) kb4[j] = r32 * C::KS + (((2 * j + hi) ^ ((r32 >> 1) & 7)) * 16);
    const int vq = (lane & 15) >> 2;
    int vb4[2];
#pragma unroll
    for (int d0 = 0; d0 < 2; ++d0) vb4[d0] = C::KBUF + (4 * hi + vq) * C::VS + ((d0 ^ (vq >> 1)) * 64) + ((lane >> 4) & 1) * 32 + (lane & 3) * 8;
    constexpr int PFK = 1, PFV = 2;
    bf16x8 kf[PFK + 1][2]; unsigned kaddr[4]; s16x4 vl[PFV + 1], vh[PFV + 1]; unsigned vaddr[2]; bf16x8 pb[2][4]; float ps;
#define KRD2(slot, d) do { asm volatile("ds_read_b128 %0, %1 offset:%2" : "=v"(kf[slot][0]) : "v"(kaddr[(d) & 3]), "n"(0)); \
                           asm volatile("ds_read_b128 %0, %1 offset:%2" : "=v"(kf[slot][1]) : "v"(kaddr[(d) & 3]), "n"(32 * C::KS)); } while (0)
#define VTR2(slot, n) do { asm volatile("ds_read_b64_tr_b16 %0, %1 offset:%2" : "=v"(vl[slot]) : "v"(vaddr[(n) >> 2]), "n"(((n) & 3) * 16 * C::VS)); \
                           asm volatile("ds_read_b64_tr_b16 %0, %1 offset:%2" : "=v"(vh[slot]) : "v"(vaddr[(n) >> 2]), "n"(((n) & 3) * 16 * C::VS + 8 * C::VS)); } while (0)
#define SMCH(T0, T1, c, NE, PB) do { \
        _Pragma("unroll") for (int e_ = (NE) * (c); e_ < (NE) * (c) + (NE); ++e_) { if (e_ < 16) { T0[e_] = __builtin_amdgcn_exp2f(T0[e_]); ps += T0[e_]; } else { T1[e_ - 16] = __builtin_amdgcn_exp2f(T1[e_ - 16]); ps += T1[e_ - 16]; } } \
        if ((((NE) * ((c) + 1)) & 7) == 0) { const int s_ = ((NE) * ((c) + 1)) / 8 - 1; u32x4 w_; \
            if (s_ < 2) { w_.x = cvtpk(T0[8 * s_ + 0], T0[8 * s_ + 1]); w_.y = cvtpk(T0[8 * s_ + 2], T0[8 * s_ + 3]); w_.z = cvtpk(T0[8 * s_ + 4], T0[8 * s_ + 5]); w_.w = cvtpk(T0[8 * s_ + 6], T0[8 * s_ + 7]); } \
            else { w_.x = cvtpk(T1[8 * (s_ - 2) + 0], T1[8 * (s_ - 2) + 1]); w_.y = cvtpk(T1[8 * (s_ - 2) + 2], T1[8 * (s_ - 2) + 3]); w_.z = cvtpk(T1[8 * (s_ - 2) + 4], T1[8 * (s_ - 2) + 5]); w_.w = cvtpk(T1[8 * (s_ - 2) + 6], T1[8 * (s_ - 2) + 7]); } \
            PB[s_] = __builtin_bit_cast(bf16x8, w_); } } while (0)
#define QK_BLK(S0, S1, QI, DOSM, T0, T1, PB) do { \
        asm volatile("s_waitcnt lgkmcnt(0)" ::: "memory"); \
        KRD2(0, 0); \
        _Pragma("unroll") for (int d0 = 0; d0 < 4; ++d0) { \
            if (d0 + 1 < 4) { KRD2((d0 + 1) & 1, d0 + 1); asm volatile("s_waitcnt lgkmcnt(2)" ::: "memory"); } else asm volatile("s_waitcnt lgkmcnt(0)" ::: "memory"); \
            __builtin_amdgcn_sched_barrier(0); \
            S0 = mfma32(kf[d0 & 1][0], qf[QI][d0], S0); S1 = mfma32(kf[d0 & 1][1], qf[QI][d0], S1); \
            __builtin_amdgcn_sched_barrier(0); \
            if (DOSM) { SMCH(T0, T1, d0, 8, PB); __builtin_amdgcn_sched_barrier(0); } \
        } } while (0)
#define PV_BLK(QI, PBU, DOSM, T0, T1, PB) do { \
        asm volatile("s_waitcnt lgkmcnt(0)" ::: "memory"); \
        _Pragma("unroll") for (int i = 0; i < PFV; ++i) VTR2(i, i); \
        _Pragma("unroll") for (int i = 0; i < 8; ++i) { \
            if (i + PFV < 8) { VTR2((i + PFV) % (PFV + 1), i + PFV); asm volatile("s_waitcnt lgkmcnt(%0)" :: "n"(2 * PFV) : "memory"); } \
            else asm volatile("s_waitcnt lgkmcnt(%0)" :: "n"(2 * (7 - i)) : "memory"); \
            __builtin_amdgcn_sched_barrier(0); \
            { const s16x4 lo = vl[i % (PFV + 1)], hh = vh[i % (PFV + 1)]; \
              const bf16x8 vf = (bf16x8){lo[0], lo[1], lo[2], lo[3], hh[0], hh[1], hh[2], hh[3]}; \
              oT[QI][i >> 2] = mfma32(vf, PBU[i & 3], oT[QI][i >> 2]); } \
            __builtin_amdgcn_sched_barrier(0); \
            if (DOSM) { SMCH(T0, T1, i, 4, PB); __builtin_amdgcn_sched_barrier(0); } \
        } } while (0)
#define MASKQ(T0, T1, QI) do { const int qwi_ = qw0 + 32 * (QI); if (kb + 63 > qwi_) { const int dq = qwi_ + r32 - kb - 4 * hi; \
        _Pragma("unroll") for (int r = 0; r < 16; ++r) { const int c = (r & 3) + 8 * (r >> 2); if (c > dq) T0[r] = -__builtin_inff(); if (c + 32 > dq) T1[r] = -__builtin_inff(); } } } while (0)
    int stg = 0;
    for (int t = t0; t < NT; ++t) {
        if (t + 1 < NT) asm volatile("s_waitcnt vmcnt(%0)" :: "n"(C::G) : "memory"); else asm volatile("s_waitcnt vmcnt(0)" ::: "memory");
        asm volatile("s_waitcnt lgkmcnt(0)" ::: "memory");
        __builtin_amdgcn_s_barrier();
        if (t + 2 < NT) { const int s2 = stg >= 1 ? stg - 1 : 2; ATT_DMA(s2); }
        const LAS char* sbase = lds + stg * C::STAGE;
#pragma unroll
        for (int sub = 0; sub < 2; ++sub) {
            const int kb = t * C::KT + 64 * sub;
            if (kb > qw0 + 63) continue;
            const LAS char* sk = sbase + sub * 64 * C::KS; const LAS char* sv = sbase + sub * 64 * C::VS;
            f32x16 pa0, pa1, pc0, pc1;
#pragma unroll
            for (int g = 0; g < 4; ++g) { const f32x4 b0 = *(const LAS f32x4*)(sbase + C::KBUF + C::VBUF + (64 * sub + 8 * g + 4 * hi) * 4), b1 = *(const LAS f32x4*)(sbase + C::KBUF + C::VBUF + (64 * sub + 32 + 8 * g + 4 * hi) * 4);
#pragma unroll
                for (int j = 0; j < 4; ++j) { pa0[4 * g + j] = cq[0] - b0[j]; pa1[4 * g + j] = cq[0] - b1[j]; pc0[4 * g + j] = cq[1] - b0[j]; pc1[4 * g + j] = cq[1] - b1[j]; } }
#pragma unroll
            for (int j = 0; j < 4; ++j) kaddr[j] = (unsigned)(uintptr_t)(sk + kb4[j]);
#pragma unroll
            for (int d0 = 0; d0 < 2; ++d0) vaddr[d0] = (unsigned)(uintptr_t)(sv + vb4[d0]);
            QK_BLK(pa0, pa1, 0, false, pc0, pc1, pb[1]);
            MASKQ(pa0, pa1, 0);
            ps = 0.f; QK_BLK(pc0, pc1, 1, true, pa0, pa1, pb[0]); l_run[0] += ps;
            MASKQ(pc0, pc1, 1);
            ps = 0.f; PV_BLK(0, pb[0], true, pc0, pc1, pb[1]); l_run[1] += ps;
            PV_BLK(1, pb[1], false, pa0, pa1, pb[0]);
        }
        stg = stg == 2 ? 0 : stg + 1;
    }
    asm volatile("s_waitcnt lgkmcnt(0)" ::: "memory");
    __builtin_amdgcn_s_barrier();
#pragma unroll
    for (int qi = 0; qi < 2; ++qi) {
        float l = l_run[qi]; l += __shfl_xor(l, 32);
        const float il = (F8_P4 ? F8_SX : 1.0f) / l; unsigned char* orow = P.O + (size_t)(qw0 + 32 * qi + r32) * P.op + (F8_P4 ? 4 : 8) * hi;
#pragma unroll
        for (int d0 = 0; d0 < 2; ++d0)
#pragma unroll
            for (int g = 0; g < 4; ++g) { const f32x4 ov = (f32x4){oT[qi][d0][4 * g] * il, oT[qi][d0][4 * g + 1] * il, oT[qi][d0][4 * g + 2] * il, oT[qi][d0][4 * g + 3] * il};
                if (F8_P4) *(unsigned*)(orow + 32 * d0 + 8 * g) = pk4_fp8(ov); else *(u32x2*)(orow + 64 * d0 + 16 * g) = pk4(ov); }
    }
#undef ATT_DMA
#undef KRD2
#undef VTR2
#undef SMCH
#undef QK_BLK
#undef PV_BLK
#undef MASKQ
}
__device__ __forceinline__ float absmax_vec(const float* g, int n) {
    int l = threadIdx.x; asm volatile("" : "+v"(l)); l &= 63; float m = (l < n) ? fabsf(g[l]) : 0.f; if (l + 64 < n) m = fmaxf(m, fabsf(g[l + 64]));
    int mi = __builtin_bit_cast(int, m);
    mi = max(mi, __builtin_amdgcn_ds_swizzle(mi, (1 << 10) | 0x1f)); mi = max(mi, __builtin_amdgcn_ds_swizzle(mi, (2 << 10) | 0x1f)); mi = max(mi, __builtin_amdgcn_ds_swizzle(mi, (4 << 10) | 0x1f));
    mi = max(mi, __builtin_amdgcn_ds_swizzle(mi, (8 << 10) | 0x1f)); mi = max(mi, __builtin_amdgcn_ds_swizzle(mi, (16 << 10) | 0x1f));
    const int a0 = __builtin_amdgcn_readlane(mi, 0), a1 = __builtin_amdgcn_readlane(mi, 32);
    return __builtin_bit_cast(float, a0 > a1 ? a0 : a1); }
template <bool MLA, int VAR = 0>
__device__ __forceinline__ void attn_phase_fast(const Args& a, char* lds, int qslot = 0) {
    unsigned char* ws = a.ws; constexpr int NH = MLA ? 8 : 16; constexpr int NQB = SEQ / AttnCfg<MLA>::UR, NPAIR = NQB / 2; constexpr int NITEMS = BATCH * NH * NPAIR;
    float MB;
    if (MLA) MB = C2_MLA * (128.f * absmax_vec(a.in[8], 128) * absmax_vec(a.in[10], 128) + 64.f * absmax_vec(a.in[9], 64) * absmax_vec(a.in[11], 64));
    else MB = C2_FOX * 64.f * absmax_vec(a.in[12], 64) * absmax_vec(a.in[13], 64);
    MB = MB * 1.02f + 0.25f;
    MB = __builtin_bit_cast(float, __builtin_amdgcn_readfirstlane(__builtin_bit_cast(int, MB)));
    if (!MLA) {
        int* qctr = (int*)(ws + WS_CTL) + 64 + qslot; volatile int* lq = (volatile int*)(lds + LDS_BYTES - 32);
        constexpr int NUNITS = BATCH * NH * NQB;
        if (threadIdx.x == 0) lq[0] = atomicAdd(qctr, 1);
        for (;;) {
            __syncthreads();
            const int u = __builtin_amdgcn_readfirstlane(lq[0]);
            __syncthreads();
            if (u >= NUNITS) break;
            const int qb = NQB - 1 - u / (BATCH * NH), bh = u % (BATCH * NH), b = bh / NH, h = bh % NH;
            const size_t rb = (size_t)b * SEQ; AttnPtrs P; const bf16_t* Z = (const bf16_t*)(ws + WS_Z) + rb * ZP;
            P.Q = Z + OFF_FQ + h * 64; P.qp = ZP; P.K1 = Z + OFF_FK + h * 64; P.k1p = ZP; P.K2 = nullptr; P.k2p = 0; P.V = Z + OFF_FV + h * 64; P.vp = ZP;
            P.O = (unsigned char*)(ws + WS_OF) + (rb * 1024 + h * 64) * (F8_P4 ? 1 : 2); P.op = F8_P4 ? 1024 : 2048; P.F2 = (const float*)(ws + WS_FC) + ((size_t)b * 16 + h) * SEQ;
#if ATT_F8
            if (VAR == 0) { AttnPtrs8 P8; P8.Q = (const unsigned char*)(ws + WS_FQ8) + rb * 1024 + h * 64; P8.qp = 1024; P8.K1 = (const unsigned char*)(ws + WS_FK8) + rb * 1024 + h * 64; P8.k1p = 1024; P8.K2 = nullptr; P8.k2p = 0;
                P8.V = P.V; P8.vp = P.vp; P8.O = P.O; P8.op = P.op; P8.F2 = P.F2; P8.FR = ws + WS_FCR + (((size_t)b * 16 + h) * SEQ) * 16; attn_unit8<false>(P8, qb, lds, MB, qctr); continue; } else
#elif FOX_PIPE
            if (VAR == 0) attn_unit_fox_pipe(P, qb, lds, MB); else
#endif
            attn_unit<MLA, VAR>(P, qb, lds, MB);
            if (threadIdx.x == 0) lq[0] = atomicAdd(qctr, 1);
        }
    } else {
#if MLA_XCD1 && ATT_F8
    for (int L = blockIdx.x; L < NITEMS; L += gridDim.x) {
        const int xcd = L & 7, n = L >> 3, dr = n >> 5, c = n & 31;
#pragma unroll 1
        for (int half = 0; half < 2; ++half) { const int bh = xcd + 8 * (2 * dr + half), b = bh / NH, h = bh % NH, qb = half ? c : NQB - 1 - c; const size_t rb = (size_t)b * SEQ;
            AttnPtrs8 P8; P8.Q = (const unsigned char*)(ws + WS_QM8) + rb * 1536 + h * 192; P8.qp = 1536; P8.K1 = (const unsigned char*)(ws + WS_K8) + rb * 1024 + h * 128; P8.k1p = 1024;
            P8.K2 = (const unsigned char*)(ws + WS_KR8) + rb * 64; P8.k2p = 64; P8.V = (const bf16_t*)(ws + WS_KVM) + rb * 2048 + h * 256 + 128; P8.vp = 2048;
            P8.O = (unsigned char*)(ws + WS_OM) + (rb * 1024 + h * 128) * 2; P8.op = 2048; P8.F2 = nullptr; P8.FR = nullptr;
            attn_unit8<true>(P8, qb, lds, MB); }
    }
#else
    for (int L = blockIdx.x; L < NITEMS; L += gridDim.x) {
        const int xcd = L & 7, n = L >> 3, bhl = n / NPAIR, pair = n % NPAIR, bh = xcd + 8 * bhl, b = bh / NH, h = bh % NH;
        const size_t rb = (size_t)b * SEQ; AttnPtrs P;
        { const bf16_t* KVM = (const bf16_t*)(ws + WS_KVM);
            P.Q = (const bf16_t*)(ws + WS_QM) + rb * 1536 + h * 192; P.qp = 1536; P.K1 = KVM + rb * 2048 + h * 256; P.k1p = 2048; P.K2 = (const bf16_t*)(ws + WS_KR) + rb * 64; P.k2p = 64;
            P.V = KVM + rb * 2048 + h * 256 + 128; P.vp = 2048; P.O = (unsigned char*)(ws + WS_OM) + (rb * 1024 + h * 128) * (F8_P4 ? 1 : 2); P.op = F8_P4 ? 1024 : 2048; P.F2 = nullptr; }
#if ATT_F8
        if (VAR == 0) { AttnPtrs8 P8; P8.Q = (const unsigned char*)(ws + WS_QM8) + rb * 1536 + h * 192; P8.qp = 1536; P8.K1 = (const unsigned char*)(ws + WS_K8) + rb * 1024 + h * 128; P8.k1p = 1024;
            P8.K2 = (const unsigned char*)(ws + WS_KR8) + rb * 64; P8.k2p = 64; P8.V = P.V; P8.vp = P.vp; P8.O = P.O; P8.op = P.op; P8.F2 = nullptr; P8.FR = nullptr;
            attn_unit8<true>(P8, NQB - 1 - pair, lds, MB); attn_unit8<true>(P8, pair, lds, MB); } else
#elif MLA_PIPE
        if (VAR == 0) { attn_unit_mla_pipe(P, NQB - 1 - pair, lds, MB); attn_unit_mla_pipe(P, pair, lds, MB); } else
#endif
        { attn_unit<MLA, VAR>(P, NQB - 1 - pair, lds, MB);
        attn_unit<MLA, VAR>(P, pair, lds, MB); }
    }
#endif
    }
}

__device__ __forceinline__ void phase_router(const Args& a, char* lds, int wave, int lane) {
    unsigned char* ws = a.ws; const int tid = threadIdx.x;
    int* sel_e = (int*)lds;
    float* sel_g = (float*)(lds + 2048);
    int* rnk = (int*)(lds + 4096);
    int* lcnt = (int*)(lds + 6144);
    int* lbase = lcnt + 32;
    float* sel_r = (float*)(lbase + 32);
    const bf16_t* X1B = (const bf16_t*)(ws + WS_X1B); float* RSTD2 = (float*)(ws + WS_RSTD2); const bf16_t* WR3 = (const bf16_t*)(ws + WS_WR3);
    const float* b_router = a.in[20];
    int* CNT = (int*)(ws + WS_CTL); int* LIST = (int*)(ws + WS_LIST); float* GATE = (float*)(ws + WS_GATE);
    unsigned char* X1F8 = (unsigned char*)(ws + WS_X1F8);
    if (blockIdx.x == 0) { if (tid < 64) *((u32x4*)(X1F8 + (size_t)NTOK * DM) + tid) = (u32x4){0u, 0u, 0u, 0u}; if (tid == 0) RSTD2[NTOK] = 0.f; }
    const int r32 = lane & 31, hi = lane >> 5;
    for (int chunk = blockIdx.x; chunk < NTOK / 128; chunk += gridDim.x) {
        if (tid < 32) lcnt[tid] = 0;
        if (wave < 4) {
            const int lt = 32 * wave + r32, t = chunk * 128 + lt;
            const bf16_t* xr = X1B + (size_t)t * DM + 8 * hi; const bf16_t* wrow = WR3 + (size_t)r32 * 1024 + 8 * hi;
            f32x16 C;
#pragma unroll
            for (int r = 0; r < 16; ++r) C[r] = 0.f;
            float ss = 0.f;
            u32x4 xq[8];
#pragma unroll
            for (int i = 0; i < 8; ++i) xq[i] = *(const u32x4*)(xr + i * 16);
#pragma unroll 1
            for (int kg = 0; kg < 16; kg += 2)
#pragma unroll
            for (int kl = 0; kl < 2; ++kl) { const int kb = kg + kl;
                bf16x8 wf[4][3];
#pragma unroll
                for (int i = 0; i < 4; ++i)
#pragma unroll
                    for (int tm = 0; tm < 3; ++tm) wf[i][tm] = *(const bf16x8*)(wrow + tm * 32768 + (kb * 4 + i) * 16);
                u32x4 cur[4];
#pragma unroll
                for (int i = 0; i < 4; ++i) cur[i] = xq[kl * 4 + i];
                if (kb + 2 < 16) {
#pragma unroll
                    for (int i = 0; i < 4; ++i) xq[kl * 4 + i] = *(const u32x4*)(xr + ((kb + 2) * 4 + i) * 16); }
                __builtin_amdgcn_sched_barrier(0);
#pragma unroll
                for (int i = 0; i < 4; ++i) { const int k0 = (kb * 4 + i) * 16; const u32x4 xw = cur[i];
                    { const f32x4 a0 = unpk4((u32x2){xw.x, xw.y}), a1 = unpk4((u32x2){xw.z, xw.w}); ss += (a0[0] * a0[0] + a0[1] * a0[1]) + (a0[2] * a0[2] + a0[3] * a0[3]) + (a1[0] * a1[0] + a1[1] * a1[1]) + (a1[2] * a1[2] + a1[3] * a1[3]);
                      *(u32x2*)(X1F8 + (size_t)t * DM + k0 + 8 * hi) = (u32x2){pk4_fp8s(a0 * F8_SX), pk4_fp8s(a1 * F8_SX)}; }
                    const bf16x8 xb = __builtin_bit_cast(bf16x8, xw);
#pragma unroll
                    for (int tm = 0; tm < 3; ++tm) C = mfma32(wf[i][tm], xb, C); }
                __builtin_amdgcn_sched_barrier(0);
            }
            ss += __shfl_xor(ss, 32);
            const float rs = __builtin_amdgcn_rsqf(ss * (1.0f / DM) + EPS);
            float t0 = -3.0e38f, t1 = -3.0e38f, t2 = -3.0e38f, t3 = -3.0e38f; int i0 = 0, i1 = 0, i2 = 0, i3 = 0;
#define TOPINS(x, e) do { const float x_ = (x); const int e_ = (e); \
                if (x_ > t3 || (x_ == t3 && e_ < i3)) { if (x_ > t2 || (x_ == t2 && e_ < i2)) { t3 = t2; i3 = i2; if (x_ > t1 || (x_ == t1 && e_ < i1)) { t2 = t1; i2 = i1; if (x_ > t0 || (x_ == t0 && e_ < i0)) { t1 = t0; i1 = i0; t0 = x_; i0 = e_; } else { t1 = x_; i1 = e_; } } else { t2 = x_; i2 = e_; } } else { t3 = x_; i3 = e_; } } } while (0)
#pragma unroll
            for (int r = 0; r < 16; ++r) { const int e = (r & 3) + 8 * (r >> 2) + 4 * hi; TOPINS(C[r] * rs + b_router[e], e); }
            { const float p0 = __shfl_xor(t0, 32), p1 = __shfl_xor(t1, 32), p2 = __shfl_xor(t2, 32), p3 = __shfl_xor(t3, 32);
              const int q0 = __shfl_xor(i0, 32), q1 = __shfl_xor(i1, 32), q2 = __shfl_xor(i2, 32), q3 = __shfl_xor(i3, 32);
              TOPINS(p0, q0); TOPINS(p1, q1); TOPINS(p2, q2); TOPINS(p3, q3); }
#undef TOPINS
            const float e1 = __expf(t1 - t0), e2 = __expf(t2 - t0), e3 = __expf(t3 - t0), inv = 1.0f / (1.0f + e1 + e2 + e3);
            if (hi == 0) { RSTD2[t] = rs; sel_r[lt] = rs;
                sel_e[lt * 4 + 0] = i0; sel_e[lt * 4 + 1] = i1; sel_e[lt * 4 + 2] = i2; sel_e[lt * 4 + 3] = i3;
                sel_g[lt * 4 + 0] = inv; sel_g[lt * 4 + 1] = e1 * inv; sel_g[lt * 4 + 2] = e2 * inv; sel_g[lt * 4 + 3] = e3 * inv; }
        }
        __syncthreads();
        const int my_e = sel_e[tid]; rnk[tid] = atomicAdd(&lcnt[my_e], 1);
        __syncthreads();
        if (tid < 32) lbase[tid] = atomicAdd(&CNT[tid], lcnt[tid]);
        __syncthreads();
        { const int pos = lbase[my_e] + rnk[tid]; const size_t sl = (size_t)my_e * NTOK + pos; LIST[sl] = chunk * 512 + tid; GATE[chunk * 512 + tid] = sel_g[tid];
          ((float*)(ws + WS_LISTR))[sl] = sel_r[tid >> 2]; ((float*)(ws + WS_LISTG))[sl] = sel_g[tid]; }
        __syncthreads();
    }
}

struct GatherRows { const bf16_t* X; const int* list; int idx0, cnt; __device__ __forceinline__ const bf16_t* operator()(int r) const { const int idx = idx0 + r; const int tok = idx < cnt ? (list[idx] >> 2) : NTOK; return X + (size_t)tok * DM; } };
__device__ __forceinline__ int moe_table(const int* CNT, int* tstart  , int* cnts  ) {
    if (threadIdx.x < 64) {
        const int e = threadIdx.x; const int c = (e < NEXP) ? CNT[e] : 0; const int nt = (c + 255) >> 8; int incl = nt;
#pragma unroll
        for (int o = 1; o < 32; o <<= 1) { const int u = __shfl_up(incl, o); if ((e & 63) >= o) incl += u; }
        if (e < NEXP) { cnts[e] = c; tstart[e] = incl - nt; }
        if (e == NEXP - 1) tstart[NEXP] = incl;
    }
    __syncthreads();
    int* tile_e = tstart + 128;
    int t_first = threadIdx.x; asm volatile("" : "+v"(t_first));
    for (int t = t_first; t < tstart[NEXP]; t += NTHREADS) { int e = 0; for (int q = 1; q < NEXP; ++q) if (t >= tstart[q]) e = q; tile_e[t] = e; }
    __syncthreads();
    return tstart[NEXP];
}
template <bool UP, class Epi>
__device__ __forceinline__ void moe_gemm_simple(const Args& a, char* lds, const Epi& E, int wave, int lane) {
    unsigned char* ws = a.ws; int* tstart = (int*)lds; int* cnts = tstart + 64;
    const int T = moe_table((const int*)(ws + WS_CTL), tstart, cnts);
    constexpr int NPN = UP ? 8 : 4;
    const int* LIST = (const int*)(ws + WS_LIST);
    for (int u = blockIdx.x; u < T * NPN; u += gridDim.x) {
        const int t = u / NPN, pn = u % NPN; int e = 0;
        for (int q = 1; q < NEXP; ++q) if (t >= tstart[q]) e = q;
        UnitCtx uc; uc.row0 = t * 256; uc.e = e; uc.idx0 = (t - tstart[e]) * 256; uc.cnt = cnts[e]; uc.list = LIST + (size_t)e * NTOK;
        if (UP) { GatherRows RP{(const bf16_t*)(ws + WS_X1B), uc.list, uc.idx0, uc.cnt};
            gemm_unit_simple(RP, (const bf16_t*)(ws + WS_WUP) + ((size_t)e * 2048 + pn * 256) * 1024, 1024, 1024, pn * 256, uc, E, wave, lane); }
        else { DenseRows RP{(const bf16_t*)(ws + WS_H) + (size_t)t * 256 * EFF, EFF};
            gemm_unit_simple(RP, (const bf16_t*)(ws + WS_WDOWN) + ((size_t)e * 1024 + pn * 256) * 1024, 1024, 1024, pn * 256, uc, E, wave, lane); }
    }
}


template <bool UP> struct MoeSched { const char* Abase; const char* Wbase; const int* tstart; const int* cnts; const int* LIST; pg8::StaticOrder so;
    __device__ __forceinline__ bool next(int i, pg8::GUnit& u) const { pg8::Unit t; if (!so.next(i, t)) return false;
        const int e = __builtin_amdgcn_readfirstlane(tstart[128 + t.pm]);
        u.uc.row0 = t.pm * 256; u.uc.e = e; u.uc.idx0 = (t.pm - __builtin_amdgcn_readfirstlane(tstart[e])) * 256; u.uc.cnt = __builtin_amdgcn_readfirstlane(cnts[e]); u.uc.list = LIST + (size_t)e * NTOK; u.colbase = t.pn * 256;
        if (UP) { u.A = Abase; u.B = Wbase + ((size_t)e * 2048 + t.pn * 256) * 1024; }
        else { u.A = Abase + (size_t)t.pm * 256 * EFF; u.B = Wbase + ((size_t)e * 1024 + t.pn * 256) * 1024; }
        return true; }
    __device__ __forceinline__ void gather_prefetch(const pg8::GUnit& u, unsigned char* dst, int lane) const {
        asm volatile("" : "+v"(lane));
        __builtin_amdgcn_global_load_lds((const unsigned*)(u.uc.list + u.uc.idx0 + lane * 4), (LAS unsigned*)dst, 16, 0, 0); }
    __device__ __forceinline__ void gather_from_lds(const pg8::GUnit& u, const int* g, const int (&Rr)[2], const int (&Cc)[2], unsigned (&off)[2][2], int RB) const {
        const int lim = u.uc.cnt - 1 - u.uc.idx0;
#pragma unroll
        for (int h = 0; h < 2; ++h)
#pragma unroll
            for (int i = 0; i < 2; ++i) { const int li = min(Rr[i] + 128 * h, lim); off[h][i] = (unsigned)(g[li] >> 2) * (unsigned)RB + (unsigned)Cc[i] * 2u; }
    }
    __device__ __forceinline__ void gather_offsets(const pg8::GUnit& u, const int (&Rr)[2], const int (&Cc)[2], unsigned (&off)[2][2], int RB) const {
#pragma unroll
        for (int h = 0; h < 2; ++h)
#pragma unroll
            for (int i = 0; i < 2; ++i) { const int idx = min(u.uc.idx0 + Rr[i] + 128 * h, u.uc.cnt - 1);
                off[h][i] = (unsigned)(u.uc.list[idx] >> 2) * (unsigned)RB + (unsigned)Cc[i] * 2u; }
    }
};
template <bool UP, class Epi>
__device__ __forceinline__ void moe_gemm_fast(const Args& a, char* lds, const Epi& E) {
    unsigned char* ws = a.ws; int* tstart = (int*)(lds + 131072); int* cnts = tstart + 64;
    const int T = moe_table((const int*)(ws + WS_CTL), tstart, cnts);
    MoeSched<UP> S; S.Abase = UP ? (const char*)(ws + WS_X1F8) : (const char*)(ws + WS_H); S.Wbase = UP ? (const char*)(ws + WS_WUP) : (const char*)(ws + WS_WDOWN);
    S.tstart = tstart; S.cnts = cnts; S.LIST = (const int*)(ws + WS_LIST); S.so.init(T, UP ? 8 : 4, (int)gridDim.x, (int)blockIdx.x, UP ? WGM_UP : WGM_DOWN);
    pg8::gemm_phase<Epi, MoeSched<UP>, UP, true>((LAS unsigned char*)lds, 1024, S, E);
}

__device__ __forceinline__ void phase_combine(const Args& a, int gw, int ngw, int lane) {
    unsigned char* ws = a.ws; const bf16_t* X1B = (const bf16_t*)(ws + WS_X1B); const bf16_t* Y = (const bf16_t*)(ws + WS_Y); bf16_t* X2B = (bf16_t*)(ws + WS_X2B); float* RSTD3 = (float*)(ws + WS_RSTD3);
    u32x2 yq[2][4][4], xq[2][4];
#define CMB_LD(t_, s_) do { _Pragma("unroll") for (int j = 0; j < 4; ++j) { _Pragma("unroll") for (int k = 0; k < 4; ++k) yq[s_][j][k] = *((const u32x2*)(Y + ((size_t)(t_) * 4 + k) * DM) + lane + 64 * j); \
            xq[s_][j] = *((const u32x2*)(X1B + (size_t)(t_) * DM) + lane + 64 * j); } } while (0)
    int t = gw; if (t < NTOK) CMB_LD(t, 0);
    for (; t < NTOK; t += 2 * ngw) {
#pragma unroll
        for (int s_ = 0; s_ < 2; ++s_) { const int tc = t + s_ * ngw, tn = tc + ngw; if (tc >= NTOK) break;
            if (tn < NTOK) { if (s_ == 0) CMB_LD(tn, 1); else CMB_LD(tn, 0); }
            __builtin_amdgcn_sched_barrier(0);
            float ss = 0.f; f32x4 v[4];
#pragma unroll
            for (int j = 0; j < 4; ++j) { f32x4 y = (f32x4){0.f, 0.f, 0.f, 0.f};
#pragma unroll
                for (int k = 0; k < 4; ++k) y = y + unpk4(yq[s_][j][k]);
                v[j] = unpk4(xq[s_][j]) + y; ss += (v[j][0] * v[j][0] + v[j][1] * v[j][1]) + (v[j][2] * v[j][2] + v[j][3] * v[j][3]); }
            ss = wave_sum(ss);
            if (lane == 0) RSTD3[tc] = __builtin_amdgcn_rsqf(ss * (1.0f / DM) + EPS);
            u32x2* xb = (u32x2*)(X2B + (size_t)tc * DM) + lane; unsigned* x8 = (unsigned*)(ws + WS_X2F8 + (size_t)tc * DM) + lane;
#pragma unroll
            for (int j = 0; j < 4; ++j) { xb[64 * j] = pk4(v[j]); x8[64 * j] = pk4_fp8s(v[j] * F8_SX); }
            __builtin_amdgcn_sched_barrier(0);
        }
    }
#undef CMB_LD
}

#ifndef FAST_MLA
#define FAST_MLA 1
#endif
#ifndef FAST_FOX
#define FAST_FOX 1
#endif
#ifndef FAST_MOE
#define FAST_MOE 1
#endif
#if FAST_MOE
#define MOE_GEMM(UP_, E_) moe_gemm_fast<UP_>(a, lds, E_)
#else
#define MOE_GEMM(UP_, E_) moe_gemm_simple<UP_>(a, lds, E_, wave, lane)
#endif
#ifndef FAST_DENSE
#define FAST_DENSE 1
#endif
#if FAST_DENSE
#define GEMM_DENSE(A_, lda_, Bt_, M_, N_, K_, E_) gemm_dense_fast(lds, A_, Bt_, M_, N_, K_, E_)
#define GEMM_DENSE8(A_, Bt_, M_, N_, K_, E_) gemm_dense_fast<decltype(E_), true>(lds, A_, Bt_, M_, N_, K_, E_)
#else
#define GEMM_DENSE(A_, lda_, Bt_, M_, N_, K_, E_) gemm_dense(A_, lda_, Bt_, M_, N_, K_, E_, wave, lane)
#endif
#define XB_TMO      128
#define XB_XCNT(j)  (256  + 64 * (j))
#define XB_XSUB(j)  (1280 + 64 * (j))
#define XB_XGEN(j)  (2304 + 64 * (j))
#define XB_TOP      3328
#define XB_TOPGEN   3392
#define XCD_BAR_WORDS 3456
#define XB_SPIN_CAP (1u << 22)
__device__ __forceinline__ unsigned xb_ld(unsigned* p)              { return __hip_atomic_load(p, __ATOMIC_RELAXED, __HIP_MEMORY_SCOPE_AGENT); }
__device__ __forceinline__ unsigned xb_add(unsigned* p, unsigned v) { return __hip_atomic_fetch_add(p, v, __ATOMIC_RELAXED, __HIP_MEMORY_SCOPE_AGENT); }
__device__ __forceinline__ unsigned xb_xcc_id() { return (unsigned)__builtin_amdgcn_s_getreg((3 << 11) | 20) & 0xFu; }
#define XB_SPIN(cond, bar) do { unsigned _sp = 0; while (cond) { __builtin_amdgcn_s_sleep(1); \
    if ((++_sp & 255u) == 0u) { if (xb_ld(&(bar)[XB_TMO])) break; if (_sp > XB_SPIN_CAP) { atomicAdd(&(bar)[XB_TMO], 1u); break; } } } } while (0)
struct XcdBarrier { unsigned* bar; unsigned x; volatile LAS unsigned* st; };
__device__ __forceinline__ XcdBarrier xcd_barrier_post(unsigned* bar, volatile LAS unsigned* st) {
    XcdBarrier b; b.bar = bar; b.x = xb_xcc_id(); b.st = st;
    if (threadIdx.x == 0) (void)xb_add(&bar[XB_XCNT(b.x)], 1u);
    return b;
}
__device__ __forceinline__ void xcd_barrier_complete(unsigned* bar, unsigned x, unsigned& nloc, unsigned& nx) {
    const unsigned G = gridDim.x * gridDim.y * gridDim.z;
    unsigned sum, cnt, mine, sp = 0u;
    for (;;) {
        sum = 0u; cnt = 0u; mine = 0u;
#pragma unroll
        for (unsigned j = 0; j < 16; ++j) { const unsigned c = xb_ld(&bar[XB_XCNT(j)]); sum += c; cnt += (c > 0u) ? 1u : 0u; mine = (j == x) ? c : mine; }
        if (sum == G) break;
        __builtin_amdgcn_s_sleep(1);
        if ((++sp & 255u) == 0u) { if (xb_ld(&bar[XB_TMO])) break; if (sp > XB_SPIN_CAP) { atomicAdd(&bar[XB_TMO], 1u); break; } }
    }
    nloc = mine > 0u ? mine : 1u; nx = cnt > 0u ? cnt : 1u;
}
__device__ __forceinline__ void xcd_barrier(const XcdBarrier& b) {
    asm volatile("s_waitcnt vmcnt(0)" ::: "memory");
    __syncthreads();
    if (threadIdx.x == 0) {
        unsigned* bar = b.bar;
        __builtin_amdgcn_s_waitcnt(0);
        unsigned nloc = b.st[0], nx = b.st[1];
        if (nloc == 0u) { xcd_barrier_complete(bar, b.x, nloc, nx); b.st[0] = nloc; b.st[1] = nx; }
        const unsigned old = xb_add(&bar[XB_XSUB(b.x)], 1u);
        const unsigned gen = old / nloc;
        if (old + 1u == (gen + 1u) * nloc) {
            __builtin_amdgcn_fence(__ATOMIC_RELEASE, "agent");
            asm volatile("s_waitcnt vmcnt(0)" ::: "memory");
            const unsigned og = xb_add(&bar[XB_TOP], 1u);
            const unsigned tg = og / nx;
            if (og + 1u == (tg + 1u) * nx) xb_add(&bar[XB_TOPGEN], 1u);
            else XB_SPIN(xb_ld(&bar[XB_TOPGEN]) == tg, bar);
            __builtin_amdgcn_fence(__ATOMIC_ACQUIRE, "agent");
            xb_add(&bar[XB_XGEN(b.x)], 1u);
            asm volatile("s_waitcnt vmcnt(0)" ::: "memory");
        } else {
            XB_SPIN(xb_ld(&bar[XB_XGEN(b.x)]) == gen, bar);
            __builtin_amdgcn_fence(__ATOMIC_ACQUIRE, "agent");
            asm volatile("s_waitcnt vmcnt(0)" ::: "memory");
        }
    }
    __syncthreads();
}


#ifndef MFMA_BENCH
#define MFMA_BENCH 0
#endif
template <int NACC>
__device__ __forceinline__ void mfma_bench(unsigned char* ws, int lane) {
    f32x16 acc[NACC];
#pragma unroll
    for (int i = 0; i < NACC; ++i)
#pragma unroll
        for (int r = 0; r < 16; ++r) acc[i][r] = 0.f;
    bf16x8 a = (bf16x8){(short)lane, 1, 2, 3, 4, 5, 6, 7}, b = (bf16x8){1, (short)lane, 2, 3, 4, 5, 6, 7};
    asm volatile("" : "+v"(a), "+v"(b));
    for (int it = 0; it < 10000 / NACC; ++it) {
#pragma unroll
        for (int i = 0; i < NACC; ++i) acc[i] = mfma32(a, b, acc[i]);
    }
    float s = 0.f;
#pragma unroll
    for (int i = 0; i < NACC; ++i) s += acc[i][0] + acc[i][7];
    if (s == 123.456f) *(float*)(ws + WS_CTL + 60000) = s;
}
#ifndef SHADOW_P1
#define SHADOW_P1 0
#endif
#ifndef SHADOW_MLA
#define SHADOW_MLA 0
#endif
#ifndef SHADOW_FOX
#define SHADOW_FOX 0
#endif
#ifndef REP_ID
#define REP_ID -1
#endif
#ifndef REP_MASK
#define REP_MASK 0
#endif
#define NREP(id) (((REP_ID == (id)) || ((REP_MASK >> (id)) & 1)) ? 2 : 1)
__device__ __forceinline__ Args fresh_args() {
    typedef const __attribute__((address_space(4))) Args* CP; CP p = (CP)__builtin_amdgcn_kernarg_segment_ptr(); asm volatile("" : "+s"(p));
    Args r;
#pragma unroll
    for (int i = 0; i < 28; ++i) r.in[i] = p->in[i];
    r.out = p->out; r.ws = p->ws; return r;
}
#define FRESH() const Args a = fresh_args(); unsigned char* ws = a.ws; int tid_ = threadIdx.x; asm volatile("" : "+v"(tid_)); const int lane = tid_ & 63, wave = __builtin_amdgcn_readfirstlane(tid_ >> 6); const int gw = blockIdx.x * NWAVES + wave, ngw = gridDim.x * NWAVES; (void)lane; (void)wave; (void)gw; (void)ngw
__global__ void __launch_bounds__(NTHREADS, 2) fwd_megakernel(Args a_kernarg) {
    extern __shared__ __attribute__((aligned(16))) char lds[];
    cg::grid_group grid = cg::this_grid();
    grid.sync();
    const int tid = threadIdx.x;
    volatile LAS unsigned* bst = (volatile LAS unsigned*)(lds + LDS_BYTES - 64);
    if (tid < 16) bst[tid] = 0u;
    __syncthreads();
    (void)xcd_barrier_post((unsigned*)(a_kernarg.ws + WS_CTL) + 1024, bst);
#define GSYNC() do { const Args ab_ = fresh_args(); XcdBarrier xb_; xb_.bar = (unsigned*)(ab_.ws + WS_CTL) + 1024; xb_.x = xb_xcc_id(); xb_.st = (volatile LAS unsigned*)(lds + LDS_BYTES - 64); xcd_barrier(xb_); } while (0)

    for (int rep = 0; rep < NREP(0); ++rep) { { FRESH(); (void)ws; phase_prologue(a, lds, gw, ngw, wave, lane); }
    GSYNC(); }
    {   FRESH();
        EpiZHead E{(bf16_t*)(ws + WS_Z), (bf16_t*)(ws + WS_CQN), (bf16_t*)(ws + WS_CKVN), (bf16_t*)(ws + WS_KR), (unsigned char*)(ws + WS_KR8), (unsigned char*)(ws + WS_FQ8), (unsigned char*)(ws + WS_FK8), (float*)(ws + WS_LF), (const float*)(ws + WS_RSTD1), a.in[11], a.in[12], a.in[13], a.in[14], (const f32x2*)(ws + WS_ROPE)};
#if SHADOW_P1
        { EpiNull EN{(float*)(ws + WS_CTL + 61000)}; GEMM_DENSE((const bf16_t*)(ws + WS_XB), DM, (const bf16_t*)(ws + WS_WIN), NTOK, ZP, DM, EN); }
#endif
        for (int rep = 0; rep < NREP(1); ++rep) {
            if (!F8_P1) GEMM_DENSE((const bf16_t*)(ws + WS_XB), DM, (const bf16_t*)(ws + WS_WIN), NTOK, ZP, DM, E);
            else { if (P1_F8_TILE0 > 0) gemm_dense_fast(lds, ws + WS_XB, ws + WS_WIN, NTOK, 256 * P1_F8_TILE0, DM, E);
                   gemm_dense_fast<decltype(E), true>(lds, ws + WS_XF8, ws + WS_WIN8, NTOK, ZP - 256 * P1_F8_TILE0, DM, E, P1_F8_TILE0); } }
    }
    GSYNC();

    {   FRESH();
        for (int rep = 0; rep < NREP(2); ++rep) {
        phase_scan(a, lds, wave, lane);
        EpiQHead Eq{(bf16_t*)(ws + WS_QM), a.in[8], a.in[9], (const f32x2*)(ws + WS_ROPE), (unsigned char*)(ws + WS_QM8)};
        GEMM_DENSE((const bf16_t*)(ws + WS_CQN), 256, (const bf16_t*)(ws + WS_WUQ), NTOK, QPACK ? 1536 : 2048, 256, Eq);
        EpiKVHead Ekv{(bf16_t*)(ws + WS_KVM), a.in[10], (unsigned char*)(ws + WS_K8)};
        GEMM_DENSE((const bf16_t*)(ws + WS_CKVN), 256, (const bf16_t*)(ws + WS_WUKV), NTOK, 2048, 256, Ekv);
        }
    }
    GSYNC();

    {   FRESH(); (void)ws;
        const bf16_t* Z = (const bf16_t*)(ws + WS_Z);
#if FAST_MLA
#if MFMA_BENCH
        mfma_bench<MFMA_BENCH>(ws, lane);
#endif
#if SHADOW_MLA
        attn_phase_fast<true, SHADOW_MLA>(a, lds);
#endif
        for (int rep = 0; rep < NREP(3); ++rep) attn_phase_fast<true>(a, lds);
#else
        attn_simple<192, 128, 128, 64, false>((const bf16_t*)(ws + WS_QM), 1536, (const bf16_t*)(ws + WS_KVM), 2048, (const bf16_t*)(ws + WS_KR), 64, (const bf16_t*)(ws + WS_KVM) + 128, 2048,
                                          (bf16_t*)(ws + WS_OM), 1024, nullptr, 8, 192, 256, 256, 128, gw, ngw, lane);
#endif
#if FAST_FOX
#if SHADOW_FOX
        attn_phase_fast<false, SHADOW_FOX>(a, lds, 2);
#endif
        for (int rep = 0; rep < NREP(4); ++rep) attn_phase_fast<false>(a, lds, rep);
#else
        attn_simple<64, 64, 64, 64, true>(Z + OFF_FQ, ZP, Z + OFF_FK, ZP, nullptr, 0, Z + OFF_FV, ZP, (bf16_t*)(ws + WS_OF), 1024, (const float*)(ws + WS_FC), 16, 64, 64, 64, 64, gw, ngw, lane);
#endif
    }
    GSYNC();
#if P4_CHAIN && !F8_P4 && !F8_P5
    {   FRESH(); EpiMixChain E{(const bf16_t*)(ws + WS_Z), (bf16_t*)(ws + WS_MIXED)};
        gemm_chain_fast(lds, ws + WS_OM, ws + WS_WOMLA, ws + WS_OF, ws + WS_WOFOX, NTOK, DM, DM, E); }
#else
    {   FRESH(); EpiMixA E{(bf16_t*)(ws + WS_MIXTMP), (const bf16_t*)(ws + WS_Z), F8_P4 ? 1.0f / (F8_SX * F8_SW) : 1.0f};
        for (int rep = 0; rep < NREP(5); ++rep) { if (F8_P4) GEMM_DENSE8(ws + WS_OM, ws + WS_WOMLA, NTOK, DM, DM, E); else GEMM_DENSE((const bf16_t*)(ws + WS_OM), DM, (const bf16_t*)(ws + WS_WOMLA), NTOK, DM, DM, E); } }
    {   FRESH(); EpiMixB E{(const bf16_t*)(ws + WS_MIXTMP), (const bf16_t*)(ws + WS_Z), (unsigned char*)(ws + WS_MIXED), F8_P4 ? 1.0f / (F8_SX * F8_SW) : 1.0f};
        for (int rep = 0; rep < NREP(9); ++rep) { if (F8_P4) GEMM_DENSE8(ws + WS_OF, ws + WS_WOFOX, NTOK, DM, DM, E); else GEMM_DENSE((const bf16_t*)(ws + WS_OF), DM, (const bf16_t*)(ws + WS_WOFOX), NTOK, DM, DM, E); } }
#endif
    GSYNC();
    {   FRESH(); EpiResid E{a.in[0], (bf16_t*)(ws + WS_X1B), F8_P5 ? 1.0f / (F8_SX * F8_SW) : 1.0f};
        for (int rep = 0; rep < NREP(6); ++rep) { if (F8_P5) GEMM_DENSE8(ws + WS_MIXED, ws + WS_WO, NTOK, DM, DM, E); else GEMM_DENSE((const bf16_t*)(ws + WS_MIXED), DM, (const bf16_t*)(ws + WS_WO), NTOK, DM, DM, E); } }
    GSYNC();
    { FRESH(); (void)ws; phase_router(a, lds, wave, lane); }
    GSYNC();
    {   FRESH(); EpiUpW E{(bf16_t*)(ws + WS_H), (const float*)(ws + WS_LISTR), a.in[22]};
        for (int rep = 0; rep < NREP(7); ++rep) MOE_GEMM(true, E); }
    GSYNC();
    {   FRESH(); EpiDownW E{(bf16_t*)(ws + WS_Y), (const float*)(ws + WS_LISTG), a.in[24]};
        for (int rep = 0; rep < NREP(8); ++rep) MOE_GEMM(false, E); }
    GSYNC();
    for (int rep = 0; rep < NREP(12); ++rep) { FRESH(); (void)ws; phase_combine(a, gw, ngw, lane); }
    GSYNC();
    {   FRESH(); EpiF32 E{(bf16_t*)(ws + WS_TMP)};
        for (int rep = 0; rep < NREP(10); ++rep) GEMM_DENSE((const bf16_t*)(ws + WS_PB), 256, (const bf16_t*)(ws + WS_WPP), NTOK, DM, 256, E); }
    {   FRESH(); EpiPle E{a.out, (const bf16_t*)(ws + WS_X2B), (const bf16_t*)(ws + WS_TMP), (const float*)(ws + WS_RSTD3)};
        for (int rep = 0; rep < NREP(11); ++rep) { if (F8_PLE) GEMM_DENSE8(ws + WS_X2F8, ws + WS_WPG, NTOK, DM, DM, E); else GEMM_DENSE((const bf16_t*)(ws + WS_X2B), DM, (const bf16_t*)(ws + WS_WPG), NTOK, DM, DM, E); } }
}

extern "C" void kernel_launch(void* const* d_in, const int* in_sizes, int n_in, void* d_out, int out_size, void* d_ws, size_t ws_size, hipStream_t stream) {
    static int grid = 0;
    if (grid == 0) {
        if (n_in != 28 || out_size != NTOK * DM || ws_size < WS_END) { fprintf(stderr, "kernel_launch: unexpected shapes (n_in %d out %d ws %zu)\n", n_in, out_size, ws_size); grid = -1; return; }
        int dev = 0, cus = 0, per_cu = 0;
        (void)hipGetDevice(&dev); (void)hipDeviceGetAttribute(&cus, hipDeviceAttributeMultiprocessorCount, dev);
        (void)hipFuncSetAttribute((const void*)fwd_megakernel, hipFuncAttributeMaxDynamicSharedMemorySize, LDS_BYTES);
        (void)hipOccupancyMaxActiveBlocksPerMultiprocessor(&per_cu, (const void*)fwd_megakernel, NTHREADS, LDS_BYTES);
        if (per_cu < 1) { fprintf(stderr, "kernel_launch: occupancy query says %d blocks per CU\n", per_cu); per_cu = 1; }
        grid = cus * per_cu;
    }
    if (grid < 0) return;
    (void)hipMemsetAsync((char*)d_ws + WS_CTL, 0, 65536, stream);
    Args a{};
    for (int i = 0; i < 28; ++i) a.in[i] = (const float*)d_in[i];
    a.out = (float*)d_out; a.ws = (unsigned char*)d_ws;
    void* kargs[] = {&a};
    hipError_t e = hipLaunchCooperativeKernel((const void*)fwd_megakernel, dim3(grid), dim3(NTHREADS), kargs, LDS_BYTES, stream);
    if (e != hipSuccess) fprintf(stderr, "cooperative launch failed: %s (grid %d)\n", hipGetErrorString(e), grid);
}
```
